# Optimizing an MI355X kernel written in HIP

```python
import math
import jax, jax.numpy as jnp
from jax import lax
import numpy as np

D_MODEL = 4096
BATCH = 4
SEQ = 2048
DEPTH = 1
DEC_BATCH = 128
DEC_SEQ = 1
PAST_LEN = 16384
PAGE_SIZE = 128

SSM_WIDTH = D_MODEL // 2
SSM_GROUP = 16
SSM_GROUPS = SSM_WIDTH // SSM_GROUP
SSM_STATE = 64
GMLP_WIDTH = D_MODEL // 2
GMLP_HEAD = 128
GMLP_HEADS = GMLP_WIDTH // GMLP_HEAD
CHUNK = 128
D_FF = 11008
IN_WIDTH = SSM_WIDTH + 2 * GMLP_WIDTH + 2 * D_MODEL
EPS = 1e-6

kernel_name = "hybrid_s5_gmlp_macaron_decoder_step"


def rmsnorm(x, g):
    xf = x.astype(jnp.float32)
    r = lax.rsqrt(jnp.mean(xf * xf, axis=-1, keepdims=True) + EPS)
    return (xf * r * g.astype(jnp.float32)).astype(x.dtype)


def swiglu(x, w_gate, w_up, w_down):
    return (jax.nn.silu(x @ w_gate) * (x @ w_up)) @ w_down


def s5_discretise(lam_re, lam_im, log_dt, b_re, b_im):
    lam_re = lam_re.astype(jnp.float32); lam_im = lam_im.astype(jnp.float32)
    dt = jnp.exp(log_dt.astype(jnp.float32))[:, None]
    mag = jnp.exp(dt * lam_re)
    abar_re = mag * jnp.cos(dt * lam_im)
    abar_im = mag * jnp.sin(dt * lam_im)
    nr, ni = abar_re - 1.0, abar_im
    den = lam_re * lam_re + lam_im * lam_im
    coef_re = (nr * lam_re + ni * lam_im) / den
    coef_im = (ni * lam_re - nr * lam_im) / den
    b_re = b_re.astype(jnp.float32); b_im = b_im.astype(jnp.float32)
    bbar_re = coef_re[..., None] * b_re - coef_im[..., None] * b_im
    bbar_im = coef_re[..., None] * b_im + coef_im[..., None] * b_re
    return abar_re, abar_im, bbar_re, bbar_im


def _cscan_combine(e1, e2):
    a1r, a1i, b1r, b1i = e1
    a2r, a2i, b2r, b2i = e2
    return (a1r * a2r - a1i * a2i,
            a1r * a2i + a1i * a2r,
            a2r * b1r - a2i * b1i + b2r,
            a2r * b1i + a2i * b1r + b2i)


def s5_branch(u, x0_re, x0_im, lam_re, lam_im, log_dt, b_re, b_im, c_re, c_im, d_skip, w_glu):
    bsz, L, _ = u.shape
    abar_re, abar_im, bbar_re, bbar_im = s5_discretise(lam_re, lam_im, log_dt, b_re, b_im)
    ug = u.astype(jnp.float32).reshape(bsz, L, SSM_GROUPS, SSM_GROUP)
    bu_re = jnp.einsum('blgh,gph->blgp', ug, bbar_re)
    bu_im = jnp.einsum('blgh,gph->blgp', ug, bbar_im)
    x0_re = x0_re.astype(jnp.float32); x0_im = x0_im.astype(jnp.float32)
    bu_re = bu_re.at[:, 0].add(abar_re * x0_re - abar_im * x0_im)
    bu_im = bu_im.at[:, 0].add(abar_re * x0_im + abar_im * x0_re)
    a_re = jnp.broadcast_to(abar_re, bu_re.shape)
    a_im = jnp.broadcast_to(abar_im, bu_im.shape)
    _, _, s_re, s_im = lax.associative_scan(_cscan_combine, (a_re, a_im, bu_re, bu_im), axis=1)
    y = (jnp.einsum('blgp,ghp->blgh', s_re, c_re.astype(jnp.float32))
         - jnp.einsum('blgp,ghp->blgh', s_im, c_im.astype(jnp.float32))
         + d_skip.astype(jnp.float32) * ug)
    y = jax.nn.gelu(y).reshape(bsz, L, SSM_WIDTH).astype(u.dtype)
    z = y @ w_glu
    out = z[..., :D_MODEL] * jax.nn.sigmoid(z[..., D_MODEL:])
    return out, s_re[:, -1], s_im[:, -1]


def gmlp_branch(u, v, norm_v, w_s, b_s, w_gout):
    bsz, L, _ = v.shape
    v = rmsnorm(v, norm_v)
    Lp = -(-L // CHUNK) * CHUNK
    nc = Lp // CHUNK
    vp = jnp.pad(v, ((0, 0), (0, Lp - L), (0, 0))).reshape(bsz, nc, CHUNK, GMLP_HEADS, GMLP_HEAD)
    mask = jnp.tril(jnp.ones((CHUNK, CHUNK), dtype=w_s.dtype))
    ws = w_s * mask
    mixed = jnp.einsum('gts,bnsge->bntge', ws, vp) + b_s.T[:, :, None]
    mixed = mixed.reshape(bsz, Lp, GMLP_WIDTH)[:, :L]
    return (u * mixed) @ w_gout, v


def layer(x, x0_re, x0_im, prm):
    (n1, f1g, f1u, f1d, nmix, w_in, lam_re, lam_im, log_dt, b_re, b_im, c_re, c_im, d_skip, w_glu,
     gnv, w_s, b_s, w_gout, w_out, n2, f2g, f2u, f2d) = prm
    x = x + 0.5 * swiglu(rmsnorm(x, n1), f1g, f1u, f1d)
    h = rmsnorm(x, nmix)
    z = h @ w_in
    o1 = SSM_WIDTH
    o2 = o1 + GMLP_WIDTH
    o3 = o2 + GMLP_WIDTH
    o4 = o3 + D_MODEL
    ssm_in = z[..., :o1]
    gu = jax.nn.gelu(z[..., o1:o2])
    gv = jax.nn.gelu(z[..., o2:o3])
    g_ssm = jax.nn.sigmoid(z[..., o3:o4])
    g_gmlp = jax.nn.sigmoid(z[..., o4:])
    ya, s_re, s_im = s5_branch(ssm_in, x0_re, x0_im, lam_re, lam_im, log_dt, b_re, b_im,
                               c_re, c_im, d_skip, w_glu)
    yb, v_rows = gmlp_branch(gu, gv, gnv, w_s, b_s, w_gout)
    merged = g_ssm * ya + g_gmlp * yb
    x = x + merged @ w_out
    x = x + 0.5 * swiglu(rmsnorm(x, n2), f2g, f2u, f2d)
    return x, s_re, s_im, v_rows


def setup_inputs(seed: int = 0) -> dict:
    key = jax.random.key(seed)
    ks = iter(jax.random.split(key, 40))
    f32 = jnp.float32

    def nrm(shape, scale):
        return jax.random.normal(next(ks), shape, f32) * scale

    def gain(shape):
        return 1.0 + nrm(shape, 0.02)

    n_idx = jnp.arange(SSM_STATE, dtype=f32)
    lam_re = -0.5 * jnp.exp(nrm((DEPTH, SSM_GROUPS, SSM_STATE), 0.05))
    lam_im = math.pi * n_idx + nrm((DEPTH, SSM_GROUPS, SSM_STATE), 0.01)
    log_dt = jax.random.uniform(next(ks), (DEPTH, SSM_GROUPS), f32, math.log(1e-3), math.log(1e-1))
    return {
        "x_prompt": nrm((BATCH, SEQ, D_MODEL), 1.0),
        "x_sample": nrm((DEC_BATCH, DEC_SEQ, D_MODEL), 1.0),
        "state_ssm_re": nrm((DEPTH, DEC_BATCH, SSM_GROUPS, SSM_STATE), 0.3),
        "state_ssm_im": nrm((DEPTH, DEC_BATCH, SSM_GROUPS, SSM_STATE), 0.3),
        "norm_ffn1": gain((DEPTH, D_MODEL)),
        "ffn1_gate": nrm((DEPTH, D_MODEL, D_FF), D_MODEL ** -0.5),
        "ffn1_up": nrm((DEPTH, D_MODEL, D_FF), D_MODEL ** -0.5),
        "ffn1_down": nrm((DEPTH, D_FF, D_MODEL), D_FF ** -0.5),
        "norm_mix": gain((DEPTH, D_MODEL)),
        "w_in": nrm((DEPTH, D_MODEL, IN_WIDTH), D_MODEL ** -0.5),
        "ssm_lambda_re": lam_re,
        "ssm_lambda_im": lam_im,
        "ssm_log_dt": log_dt,
        "ssm_b_re": nrm((DEPTH, SSM_GROUPS, SSM_STATE, SSM_GROUP), (2 * SSM_GROUP) ** -0.5),
        "ssm_b_im": nrm((DEPTH, SSM_GROUPS, SSM_STATE, SSM_GROUP), (2 * SSM_GROUP) ** -0.5),
        "ssm_c_re": nrm((DEPTH, SSM_GROUPS, SSM_GROUP, SSM_STATE), (2 * SSM_STATE) ** -0.5),
        "ssm_c_im": nrm((DEPTH, SSM_GROUPS, SSM_GROUP, SSM_STATE), (2 * SSM_STATE) ** -0.5),
        "ssm_d": gain((DEPTH, SSM_GROUPS, SSM_GROUP)),
        "ssm_w_glu": nrm((DEPTH, SSM_WIDTH, 2 * D_MODEL), SSM_WIDTH ** -0.5),
        "gmlp_norm_v": gain((DEPTH, GMLP_WIDTH)),
        "gmlp_w_s": nrm((DEPTH, GMLP_HEADS, CHUNK, CHUNK), CHUNK ** -0.5),
        "gmlp_b_s": 1.0 + nrm((DEPTH, GMLP_HEADS, CHUNK), 0.02),
        "gmlp_w_out": nrm((DEPTH, GMLP_WIDTH, D_MODEL), GMLP_WIDTH ** -0.5),
        "w_out": nrm((DEPTH, D_MODEL, D_MODEL), D_MODEL ** -0.5),
        "norm_ffn2": gain((DEPTH, D_MODEL)),
        "ffn2_gate": nrm((DEPTH, D_MODEL, D_FF), D_MODEL ** -0.5),
        "ffn2_up": nrm((DEPTH, D_MODEL, D_FF), D_MODEL ** -0.5),
        "ffn2_down": nrm((DEPTH, D_FF, D_MODEL), D_FF ** -0.5),
        "norm_final": gain((D_MODEL,)),
    }


def reference(x_prompt, x_sample, state_ssm_re, state_ssm_im,
              norm_ffn1, ffn1_gate, ffn1_up, ffn1_down, norm_mix, w_in,
              ssm_lambda_re, ssm_lambda_im, ssm_log_dt, ssm_b_re, ssm_b_im, ssm_c_re, ssm_c_im,
              ssm_d, ssm_w_glu, gmlp_norm_v, gmlp_w_s, gmlp_b_s, gmlp_w_out, w_out,
              norm_ffn2, ffn2_gate, ffn2_up, ffn2_down, norm_final):
    yp, ys = x_prompt, x_sample
    zero_state = jnp.zeros((x_prompt.shape[0], SSM_GROUPS, SSM_STATE), jnp.float32)
    p_re, p_im, s_re, s_im, v_s = [], [], [], [], []
    for l in range(DEPTH):
        prm = (norm_ffn1[l], ffn1_gate[l], ffn1_up[l], ffn1_down[l], norm_mix[l], w_in[l],
               ssm_lambda_re[l], ssm_lambda_im[l], ssm_log_dt[l], ssm_b_re[l], ssm_b_im[l],
               ssm_c_re[l], ssm_c_im[l], ssm_d[l], ssm_w_glu[l],
               gmlp_norm_v[l], gmlp_w_s[l], gmlp_b_s[l], gmlp_w_out[l], w_out[l],
               norm_ffn2[l], ffn2_gate[l], ffn2_up[l], ffn2_down[l])
        yp, pr, pi, _ = layer(yp, zero_state, zero_state, prm)
        ys, sr, si, vr = layer(ys, state_ssm_re[l], state_ssm_im[l], prm)
        p_re.append(pr); p_im.append(pi); s_re.append(sr); s_im.append(si); v_s.append(vr)
    y_prompt = rmsnorm(yp, norm_final)
    y_sample = rmsnorm(ys, norm_final)
    return (y_prompt, y_sample, jnp.stack(p_re), jnp.stack(p_im), jnp.stack(s_re), jnp.stack(s_im), jnp.stack(v_s))
```

```cpp
#include <hip/hip_runtime.h>
#include <cstdio>
#include <cstdint>

#ifndef MK_SPLIT
#define MK_SPLIT 0
#endif

namespace pg8 {
#define PG8_LAS __attribute__((address_space(3)))
typedef unsigned short bf16_t;
typedef short bf16x8 __attribute__((ext_vector_type(8)));
typedef float f32x4 __attribute__((ext_vector_type(4)));
typedef unsigned u32x4 __attribute__((ext_vector_type(4)));
typedef unsigned u32x2 __attribute__((ext_vector_type(2)));
constexpr int BM = 256, BK = 64, HALF = 128, HTB = HALF * BK * 2  , STAGE_BYTES = 8 * HTB, NXCD = 8, WGM = 4;

__host__ __device__ __forceinline__ int lds_byte(int r, int c) { const int st = (r >> 4) * 2 + (c >> 5), rr = r & 15, cc = c & 31, ob = rr * 64 + cc * 2; return st * 1024 + (ob ^ (((ob >> 9) & 1) << 5)); }
__host__ __device__ __forceinline__ void stage_rc(int b, int& R, int& C) { const int st = b / 1024, sb = b % 1024, swz = sb ^ (((sb >> 9) & 1) << 5); R = (st >> 1) * 16 + swz / 64; C = (st & 1) * 32 + (swz % 64) / 2; }
__host__ __device__ __forceinline__ int perm32(int rho) { const int n = rho >> 4, i = rho & 15; return 8 * (i >> 2) + 4 * n + (i & 3); }

struct Unit { int pm, pn, kt0, nkt, flags; };
struct Gemm { const bf16_t* A; const bf16_t* Bt; int M, N, K; };

struct StaticOrder {
    int nM, nN, nwg, G, c;
    __host__ __device__ void init(int M, int N, int G_, int c_) { nM = M / BM; nN = N / BM; nwg = nM * nN; G = G_; c = c_; }
    __host__ __device__ bool next(int i, Unit& u) const {
        const long L = (long)i * G + c; if (L >= nwg) return false;
        int wgid = (int)L; { const int q = nwg / NXCD, r = nwg % NXCD, xcd = wgid % NXCD, off = wgid / NXCD; wgid = (xcd < r ? xcd * (q + 1) : r * (q + 1) + (xcd - r) * q) + off; }
        const int nig = WGM * nN, gid = wgid / nig, fm = gid * WGM, gsz = (nM - fm) < WGM ? (nM - fm) : WGM;
        u.pm = fm + ((wgid % nig) % gsz); u.pn = (wgid % nig) / gsz; return true;
    }
    __device__ __forceinline__ void a_ready(const Unit&) const {}
    __device__ __forceinline__ void done(const Unit&) const {}
};
struct SampleOrder {
    StaticOrder base; int fullcnt, sbase, sstride, nsamp, nN, nsplit, nkt;
    __device__ void init(int N, int K, int G, int c, int nsplit_) {
        base.init(32 * BM, N, G, c); nN = N / BM; nsplit = nsplit_; nkt = K / BK; nsamp = nN * nsplit;
        const int nfull = 32 * nN, R = nfull % G; fullcnt = nfull / G + (c < R ? 1 : 0);
        if (R > 0) { sbase = c - R; sstride = G - R; } else { sbase = c; sstride = G; }
    }
    __device__ bool next(int i, Unit& u) const {
        if (i < fullcnt) { base.next(i, u); u.kt0 = 0; u.nkt = nkt; u.flags = 0; return true; }
        if (sbase < 0) return false;
        const int s = sbase + (i - fullcnt) * sstride; if (s >= nsamp) return false;
        const int ks = s / nN, pairs = nkt >> 1, q = pairs / nsplit, r = pairs % nsplit;
        u.pm = 32; u.pn = s % nN; u.kt0 = 2 * (ks * q + (ks < r ? ks : r)); u.nkt = 2 * (q + (ks < r ? 1 : 0)); u.flags = 1 | (nsplit > 1 ? 2 : 0) | (ks << 8); return true;
    }
    __device__ __forceinline__ void a_ready(const Unit&) const {}
    __device__ __forceinline__ void done(const Unit&) const {}
};

struct SampleOrderGated : SampleOrder {
    const unsigned* ctr; unsigned nconv, base; int g0, sg; mutable unsigned seen;
    __device__ __forceinline__ void a_ready(const Unit& u) const {
        const unsigned need = base + (u.pn < g0 ? 0u : (unsigned)(1 + (u.pn - g0) / sg) * nconv);
        if (seen < need) {
            unsigned v;
            while ((v = __hip_atomic_load(ctr, __ATOMIC_RELAXED, __HIP_MEMORY_SCOPE_AGENT)) < need) __builtin_amdgcn_s_sleep(16);
            __builtin_amdgcn_fence(__ATOMIC_ACQUIRE, "workgroup");
            seen = v;
        }
    }
};

struct SampleOrderSampGate : SampleOrder {
    const unsigned* ctr; unsigned need; mutable bool open;
    __device__ __forceinline__ void a_ready(const Unit& u) const {
        if (!open && u.pm == 32) {
            while (__hip_atomic_load(ctr, __ATOMIC_RELAXED, __HIP_MEMORY_SCOPE_AGENT) < need) __builtin_amdgcn_s_sleep(16);
            __builtin_amdgcn_fence(__ATOMIC_ACQUIRE, "workgroup");
            open = true;
        }
    }
};

__device__ __forceinline__ unsigned cvt_pk_bf16(float lo, float hi) { unsigned r; asm volatile("v_cvt_pk_bf16_f32 %0, %1, %2" : "=v"(r) : "v"(lo), "v"(hi)); return r; }
__device__ __forceinline__ float bflo(unsigned w) { return __uint_as_float(w << 16); }
__device__ __forceinline__ float bfhi(unsigned w) { return __uint_as_float(w & 0xffff0000u); }
__device__ __forceinline__ float fsigmoid(float x) { return __builtin_amdgcn_rcpf(1.0f + __builtin_amdgcn_exp2f(-1.44269504089f * x)); }
__device__ __forceinline__ float fsilu(float x) { return x * fsigmoid(x); }
__device__ __forceinline__ float fgelu(float x) { const float u = x * (1.0f + 0.044715f * x * x); return x * fsigmoid(1.5957691216057308f * u); }
__device__ __forceinline__ u32x4 pack8(const f32x4 a, const f32x4 b) { u32x4 w; w.x = cvt_pk_bf16(a[0], a[1]); w.y = cvt_pk_bf16(a[2], a[3]); w.z = cvt_pk_bf16(b[0], b[1]); w.w = cvt_pk_bf16(b[2], b[3]); return w; }
__device__ __forceinline__ void unpack8(const u32x4 w, f32x4& a, f32x4& b) { a = (f32x4){bflo(w.x), bfhi(w.x), bflo(w.y), bfhi(w.y)}; b = (f32x4){bflo(w.z), bfhi(w.z), bflo(w.w), bfhi(w.w)}; }


struct EpiSwiGLU {
    static constexpr bool PERM = true, AFTER_DRAIN = false;
    bf16_t* O; int ldc;
    __device__ __forceinline__ void operator()(const f32x4 (&acc)[2][2][4][2], const Unit& u, int wr, int wc, int fr, int fq) const {
        const int row0 = u.pm * BM + wr * 64 + fr, col0 = u.pn * HALF + wc * 32 + 8 * fq; const bool half = u.flags & 1;
#pragma unroll
        for (int ai = 0; ai < 2; ++ai) { if (ai == 1 && half) continue;
#pragma unroll
            for (int m = 0; m < 4; ++m) { bf16_t* rowp = O + (size_t)(row0 + ai * HALF + m * 16) * ldc + col0;
                f32x4 v0, v1;
#pragma unroll
                for (int j = 0; j < 4; ++j) { const float g0 = acc[ai][0][m][0][j], g1 = acc[ai][0][m][1][j];
                    v0[j] = (g0 * acc[ai][1][m][0][j]) * __builtin_amdgcn_rcpf(1.0f + __builtin_amdgcn_exp2f(-g0)); v1[j] = (g1 * acc[ai][1][m][1][j]) * __builtin_amdgcn_rcpf(1.0f + __builtin_amdgcn_exp2f(-g1)); }
                *(u32x4*)rowp = pack8(v0, v1); } }
    }
};
struct EpiWin {
    static constexpr bool PERM = true, AFTER_DRAIN = false;
    bf16_t* Z0;
    size_t oGU, oGV, oGS, oGG; float* PARTW;
    __device__ __forceinline__ void operator()(const f32x4 (&acc)[2][2][4][2], const Unit& u, int wr, int wc, int fr, int fq) const {
        const int t = u.pn;
        if (u.flags & 2) {
            float* base = PARTW + ((size_t)(u.flags >> 8) * HALF + wr * 64 + fr) * 14336 + t * BM + wc * 32 + 8 * fq;
#pragma unroll
            for (int m = 0; m < 4; ++m) { float* rowp = base + (size_t)(m * 16) * 14336;
#pragma unroll
                for (int bj = 0; bj < 2; ++bj) { *(f32x4*)(rowp + bj * HALF) = acc[0][bj][m][0]; *(f32x4*)(rowp + bj * HALF + 4) = acc[0][bj][m][1]; } }
            return;
        }
        const int act = t < 8 ? 0 : (t < 24 ? 1 : 2);
        const int ldc = t < 24 ? 2048 : 4096;
        const int tl = t < 8 ? t : (t < 16 ? t - 8 : (t < 24 ? t - 16 : (t < 40 ? t - 24 : t - 40)));
        const size_t ob = t < 8 ? 0 : (t < 16 ? oGU : (t < 24 ? oGV : (t < 40 ? oGS : oGG)));
        const int row0 = u.pm * BM + wr * 64 + fr, col0 = tl * BM + wc * 32 + 8 * fq;
        bf16_t* base = Z0 + ob; const bool half = u.flags & 1;
#pragma unroll
        for (int ai = 0; ai < 2; ++ai) { if (ai == 1 && half) continue;
#pragma unroll
            for (int m = 0; m < 4; ++m) { bf16_t* rowp = base + (size_t)(row0 + ai * HALF + m * 16) * ldc + col0;
#pragma unroll
                for (int bj = 0; bj < 2; ++bj) { f32x4 v0 = acc[ai][bj][m][0], v1 = acc[ai][bj][m][1];
                    if (act == 2) {
#pragma unroll
                        for (int j = 0; j < 4; ++j) { v0[j] = __builtin_amdgcn_rcpf(1.0f + __builtin_amdgcn_exp2f(-1.44269504089f * v0[j])); v1[j] = __builtin_amdgcn_rcpf(1.0f + __builtin_amdgcn_exp2f(-1.44269504089f * v1[j])); }
                    } else if (act == 1) {
#pragma unroll
                        for (int j = 0; j < 4; ++j) { const float x0 = v0[j], x1 = v1[j];
                            v0[j] = x0 * __builtin_amdgcn_rcpf(1.0f + __builtin_amdgcn_exp2f(x0 * fmaf(x0 * x0, -0.10294324f, -2.30220820f)));
                            v1[j] = x1 * __builtin_amdgcn_rcpf(1.0f + __builtin_amdgcn_exp2f(x1 * fmaf(x1 * x1, -0.10294324f, -2.30220820f))); }
                    }
                    *(u32x4*)(rowp + bj * HALF) = pack8(v0, v1); } } }
    }
};
struct EpiGout {
    static constexpr bool PERM = true, AFTER_DRAIN = false;
    const bf16_t* GG; bf16_t* T; int ldc; float* PARTG;
    __device__ __forceinline__ void operator()(const f32x4 (&acc)[2][2][4][2], const Unit& u, int wr, int wc, int fr, int fq) const {
        const int row0 = u.pm * BM + wr * 64 + fr, col0 = u.pn * BM + wc * 32 + 8 * fq; const bool half = u.flags & 1;
        if (u.flags & 2) {
            float* base = PARTG + ((size_t)(u.flags >> 8) * HALF + wr * 64 + fr) * ldc + col0;
#pragma unroll
            for (int m = 0; m < 4; ++m) { float* rowp = base + (size_t)(m * 16) * ldc;
#pragma unroll
                for (int bj = 0; bj < 2; ++bj) { *(f32x4*)(rowp + bj * HALF) = acc[0][bj][m][0]; *(f32x4*)(rowp + bj * HALF + 4) = acc[0][bj][m][1]; } }
            return;
        }
#pragma unroll
        for (int ai = 0; ai < 2; ++ai) { if (ai == 1 && half) continue;
#pragma unroll
            for (int m = 0; m < 4; ++m) { const size_t off = (size_t)(row0 + ai * HALF + m * 16) * ldc + col0;
#pragma unroll
                for (int bj = 0; bj < 2; ++bj) { f32x4 g0, g1; unpack8(*(const u32x4*)(GG + off + bj * HALF), g0, g1);
                    *(u32x4*)(T + off + bj * HALF) = pack8(g0 * acc[ai][bj][m][0], g1 * acc[ai][bj][m][1]); } } }
    }
};
struct EpiGlu {
    static constexpr bool PERM = true, AFTER_DRAIN = false;
    const bf16_t* GS; const bf16_t* T; bf16_t* MG; int ldc; float* PARTU;
    __device__ __forceinline__ void operator()(const f32x4 (&acc)[2][2][4][2], const Unit& u, int wr, int wc, int fr, int fq) const {
        if (u.flags & 2) {
            float* base = PARTU + ((size_t)(u.flags >> 8) * HALF + wr * 64 + fr) * (2 * ldc) + u.pn * BM + wc * 32 + 8 * fq;
#pragma unroll
            for (int m = 0; m < 4; ++m) { float* rowp = base + (size_t)(m * 16) * (2 * ldc);
#pragma unroll
                for (int bj = 0; bj < 2; ++bj) { *(f32x4*)(rowp + bj * HALF) = acc[0][bj][m][0]; *(f32x4*)(rowp + bj * HALF + 4) = acc[0][bj][m][1]; } }
            return;
        }
        const int row0 = u.pm * BM + wr * 64 + fr, col0 = u.pn * HALF + wc * 32 + 8 * fq; const bool half = u.flags & 1;
#pragma unroll
        for (int ai = 0; ai < 2; ++ai) { if (ai == 1 && half) continue;
#pragma unroll
            for (int m = 0; m < 4; ++m) { const size_t off = (size_t)(row0 + ai * HALF + m * 16) * ldc + col0;
                f32x4 g0, g1, t0, t1; unpack8(*(const u32x4*)(GS + off), g0, g1);
                unpack8(*(const u32x4*)(T + off), t0, t1);
                f32x4 v0, v1;
#pragma unroll
                for (int j = 0; j < 4; ++j) { v0[j] = g0[j] * (acc[ai][0][m][0][j] * fsigmoid(acc[ai][1][m][0][j])) + t0[j]; v1[j] = g1[j] * (acc[ai][0][m][1][j] * fsigmoid(acc[ai][1][m][1][j])) + t1[j]; }
                *(u32x4*)(MG + off) = pack8(v0, v1); } }
    }
};
struct EpiRes {
    static constexpr bool PERM = true, AFTER_DRAIN = false;
    bf16_t* X; int ldc; float scale; float* PART; const float* Xp;
    __device__ __forceinline__ void operator()(const f32x4 (&acc)[2][2][4][2], const Unit& u, int wr, int wc, int fr, int fq) const {
        const int col0 = u.pn * BM + wc * 32 + 8 * fq;
        if (u.flags & 2) {
            float* base = PART + ((size_t)(u.flags >> 8) * HALF + wr * 64 + fr) * ldc + col0;
#pragma unroll
            for (int m = 0; m < 4; ++m) { float* rowp = base + (size_t)(m * 16) * ldc;
#pragma unroll
                for (int bj = 0; bj < 2; ++bj) { *(f32x4*)(rowp + bj * HALF) = acc[0][bj][m][0]; *(f32x4*)(rowp + bj * HALF + 4) = acc[0][bj][m][1]; } }
        } else {
            const int row0 = u.pm * BM + wr * 64 + fr; const bool half = u.flags & 1;
#pragma unroll
            for (int ai = 0; ai < 2; ++ai) { if (ai == 1 && half) continue;
#pragma unroll
                for (int m = 0; m < 4; ++m) { const size_t off = (size_t)(row0 + ai * HALF + m * 16) * ldc + col0;
#pragma unroll
                    for (int bj = 0; bj < 2; ++bj) { f32x4 x0, x1;
                        if (Xp) { x0 = *(const f32x4*)(Xp + off + bj * HALF); x1 = *(const f32x4*)(Xp + off + bj * HALF + 4); }
                        else unpack8(*(const u32x4*)(X + off + bj * HALF), x0, x1);
                        *(u32x4*)(X + off + bj * HALF) = pack8(x0 + acc[ai][bj][m][0] * scale, x1 + acc[ai][bj][m][1] * scale); } } }
        }
    }
};

template <class Epi, class Sched, bool ALIGN_EPI = false, bool SP2 = true>
__device__ __forceinline__ void gemm_phase(PG8_LAS unsigned char* lds, const Gemm g, const Sched& S, const Epi& E) {
    static_assert(SP2, "only the two-super-phase loop is kept");
    const int tid = threadIdx.x, wid = __builtin_amdgcn_readfirstlane(tid >> 6), lane = tid & 63, wr = wid >> 2, wc = wid & 3, fr = lane & 15, fq = lane >> 4;
    const int K = g.K;
    unsigned voffA[2], voffB[2];
#pragma unroll
    for (int i = 0; i < 2; ++i) { int R, C; stage_rc(tid * 16 + i * 8192, R, C); const int Rb = Epi::PERM ? ((R & ~31) + perm32(R & 31)) : R;
        voffA[i] = (unsigned)(R * K + C) * 2u; voffB[i] = (unsigned)(Rb * K + C) * 2u; }
    const size_t kstep = (size_t)(BK * 2);
    const size_t hstep = (size_t)HALF * K * 2;
    const size_t tstep = 2 * hstep;
    const unsigned ldsw = (unsigned)wid * 1024u;
    const int aoff = lds_byte(wr * 64 + fr, fq * 8), boff = lds_byte(wc * 32 + fr, fq * 8);
#define PG8_SA(b, h) (((b) * 2 + (h)) * HTB)
#define PG8_SB(b, h) ((4 + (b) * 2 + (h)) * HTB)
#define PG8_STAGE(bufoff, gbase, voff) do { _Pragma("unroll") for (int _i = 0; _i < 2; ++_i) \
        __builtin_amdgcn_global_load_lds((const unsigned*)((const char*)(gbase) + (voff)[_i]), (PG8_LAS unsigned*)(lds + (bufoff) + ldsw + _i * 8192), 16, 0, 0); } while (0)
#define PG8_LDA(dst, b, h) do { _Pragma("unroll") for (int m = 0; m < 4; ++m) _Pragma("unroll") for (int k = 0; k < 2; ++k) dst[m][k] = *(const PG8_LAS bf16x8*)(lds + PG8_SA(b, h) + aoff + m * 2048 + k * 1024); } while (0)
#define PG8_LDB(dst, b, h) do { _Pragma("unroll") for (int n = 0; n < 2; ++n) _Pragma("unroll") for (int k = 0; k < 2; ++k) dst[n][k] = *(const PG8_LAS bf16x8*)(lds + PG8_SB(b, h) + boff + n * 2048 + k * 1024); } while (0)
#define PG8_MMA(ai, bj, At, Bt) do { __builtin_amdgcn_s_setprio(1); _Pragma("unroll") for (int m = 0; m < 4; ++m) _Pragma("unroll") for (int n = 0; n < 2; ++n) _Pragma("unroll") for (int k = 0; k < 2; ++k) \
        acc[ai][bj][m][n] = __builtin_amdgcn_mfma_f32_16x16x32_bf16(Bt[n][k], At[m][k], acc[ai][bj][m][n], 0, 0, 0); __builtin_amdgcn_s_setprio(0); } while (0)
#define PG8_WAIT_V(n) asm volatile("s_waitcnt vmcnt(" #n ")" ::: "memory")
#define PG8_WAIT_L(n) asm volatile("s_waitcnt lgkmcnt(" #n ")" ::: "memory")
#define PG8_BAR __builtin_amdgcn_s_barrier()
#define PG8_SCHED __builtin_amdgcn_sched_barrier(0)
    Unit cur, nxt; int ui = 0;
    if (!S.next(0, cur)) return;
    f32x4 acc[2][2][4][2];
#pragma unroll
    for (int a = 0; a < 2; ++a)
#pragma unroll
        for (int b = 0; b < 2; ++b)
#pragma unroll
            for (int m = 0; m < 4; ++m)
#pragma unroll
                for (int n = 0; n < 2; ++n) acc[a][b][m][n] = (f32x4){0.f, 0.f, 0.f, 0.f};
    bf16x8 At[4][2], B0[2][2], B1[2][2];
    const char* cA = (const char*)g.A + (size_t)cur.pm * tstep + (size_t)cur.kt0 * kstep; const char* cB = (const char*)g.Bt + (size_t)cur.pn * tstep + (size_t)cur.kt0 * kstep;
    S.a_ready(cur);
    if constexpr (SP2) {
        PG8_STAGE(PG8_SB(0, 0), cB, voffB); PG8_STAGE(PG8_SB(0, 1), cB + hstep, voffB); PG8_STAGE(PG8_SA(0, 0), cA, voffA); PG8_STAGE(PG8_SA(0, 1), cA + hstep, voffA);
        if (wr == 1) PG8_BAR;
        PG8_WAIT_V(2); PG8_BAR;
        PG8_STAGE(PG8_SB(1, 0), cB + kstep, voffB); PG8_STAGE(PG8_SA(1, 0), cA + kstep, voffA); PG8_STAGE(PG8_SB(1, 1), cB + hstep + kstep, voffB);
        PG8_WAIT_V(6); PG8_BAR;
    }
    for (;;) {
        const bool has_next = S.next(ui + 1, nxt);
        const char* nA = has_next ? (const char*)g.A + (size_t)nxt.pm * tstep + (size_t)nxt.kt0 * kstep : cA; const char* nB = has_next ? (const char*)g.Bt + (size_t)nxt.pn * tstep + (size_t)nxt.kt0 * kstep : cB;
        const int nt = cur.nkt; const bool full = !(cur.flags & 1);
        for (int t = 0; t < nt; t += 2) {
            const bool last = (t == nt - 2);
            const char* a1 = cA + (size_t)(t + 1) * kstep;
            const char* a2 = last ? nA : cA + (size_t)(t + 2) * kstep; const char* b2 = last ? nB : cB + (size_t)(t + 2) * kstep;
            const char* a3 = a2 + kstep; const char* b3 = b2 + kstep;
            if (last && has_next) S.a_ready(nxt);
            if constexpr (SP2) {
            PG8_LDB(B0, 0, 0); PG8_LDB(B1, 0, 1); PG8_SCHED; PG8_LDA(At, 0, 0); PG8_STAGE(PG8_SA(1, 1), a1 + hstep, voffA);
            PG8_WAIT_V(8); PG8_WAIT_L(0); PG8_BAR; PG8_MMA(0, 0, At, B0); PG8_MMA(0, 1, At, B1); PG8_BAR; PG8_SCHED;
            if (full) { PG8_LDA(At, 0, 1); } PG8_STAGE(PG8_SB(0, 0), b2, voffB); PG8_STAGE(PG8_SB(0, 1), b2 + hstep, voffB); PG8_STAGE(PG8_SA(0, 0), a2, voffA);
            PG8_WAIT_V(8); PG8_WAIT_L(0); PG8_BAR; if (full) { PG8_MMA(1, 0, At, B0); PG8_MMA(1, 1, At, B1); } PG8_BAR; PG8_SCHED;
            PG8_LDB(B0, 1, 0); PG8_LDB(B1, 1, 1); PG8_SCHED; PG8_LDA(At, 1, 0); PG8_STAGE(PG8_SA(0, 1), a2 + hstep, voffA);
            PG8_WAIT_V(8); PG8_WAIT_L(0); PG8_BAR; PG8_MMA(0, 0, At, B0); PG8_MMA(0, 1, At, B1); PG8_BAR; PG8_SCHED;
            if (full) { PG8_LDA(At, 1, 1); } PG8_STAGE(PG8_SB(1, 0), b3, voffB); PG8_STAGE(PG8_SB(1, 1), b3 + hstep, voffB); PG8_STAGE(PG8_SA(1, 0), a3, voffA);
            PG8_WAIT_V(8); PG8_WAIT_L(0); PG8_BAR; if (full) { PG8_MMA(1, 0, At, B0); PG8_MMA(1, 1, At, B1); } PG8_BAR; PG8_SCHED;
            }
        }
        if constexpr (ALIGN_EPI) { if (wr == 0) PG8_BAR; }
        E(acc, cur, wr, wc, fr, fq); S.done(cur);
        if (!has_next) break;
#pragma unroll
        for (int a = 0; a < 2; ++a)
#pragma unroll
            for (int b = 0; b < 2; ++b)
#pragma unroll
                for (int m = 0; m < 4; ++m)
#pragma unroll
                    for (int n = 0; n < 2; ++n) acc[a][b][m][n] = (f32x4){0.f, 0.f, 0.f, 0.f};
        cur = nxt; cA = nA; cB = nB; ++ui;
        if constexpr (ALIGN_EPI) { if (wr == 1) PG8_BAR; }
    }
    PG8_WAIT_V(0);
    if constexpr (!ALIGN_EPI) { if (wr == 0) PG8_BAR; }
    PG8_BAR;
#undef PG8_SA
#undef PG8_SB
#undef PG8_STAGE
#undef PG8_LDA
#undef PG8_LDB
#undef PG8_MMA
#undef PG8_WAIT_V
#undef PG8_WAIT_L
#undef PG8_BAR
#undef PG8_SCHED
}
}

#ifndef PG8_SP2
#define PG8_SP2 true
#endif
#ifndef PG8_ALIGN
#define PG8_ALIGN true
#endif

constexpr int NWAVES = 8;
constexpr int D = 4096, NPROMPT = 8192, SEQ = 2048, NB = 4, NSAMP = 128, MREAL = NPROMPT + NSAMP, M = 8448  ;
constexpr int DFF = 11008, INW = 14336, SW = 2048, GW = 2048, NGRP = 128, NST = 64, GCH = 16, NHEAD = 16, HD = 128, CHUNK = 128;
constexpr int TCH = 64, NCH = SEQ / TCH;
constexpr float EPS = 1e-6f;
constexpr int N_PHASES = 14;
#ifndef MK_UP2_SPLIT
#define MK_UP2_SPLIT 12
#endif
constexpr int UP2_SPLIT = MK_UP2_SPLIT;
#ifndef MK_NG1
#define MK_NG1 224
#endif
#ifndef MK_NG4
#define MK_NG4 224
#endif
constexpr int NG4 = MK_NG4;
#ifndef MK_NG11
#define MK_NG11 240
#endif
constexpr int NG11 = MK_NG11;
constexpr int NG1 = MK_NG1;
constexpr size_t O_YP = 0, O_YS = (size_t)NPROMPT * D, O_PRE = O_YS + (size_t)NSAMP * D, O_PIM = O_PRE + (size_t)NB * NGRP * NST, O_SRE = O_PIM + (size_t)NB * NGRP * NST,
                 O_SIM = O_SRE + (size_t)NSAMP * NGRP * NST, O_V = O_SIM + (size_t)NSAMP * NGRP * NST, O_END = O_V + (size_t)NSAMP * GW;

constexpr size_t MiB = 1u << 20;
constexpr size_t WS_CTL = 0, CTL_ZERO_BYTES = 32768;
constexpr size_t WS_ABAR = 1 * MiB;
constexpr size_t WS_AT = WS_ABAR + 65536;
constexpr size_t WS_BB = WS_AT + 65536;
constexpr size_t WS_RS = 3 * MiB;
constexpr size_t WS_E = 4 * MiB;
constexpr size_t WS_WGU1 = 12 * MiB, WS_WD1 = 184 * MiB, WS_WIN = 270 * MiB, WS_WGLU = 382 * MiB, WS_WGOUT = 414 * MiB, WS_WOUT = 430 * MiB, WS_WGU2 = 462 * MiB, WS_WD2 = 634 * MiB;
constexpr size_t WS_XRES = 720 * MiB;
constexpr size_t WS_XSAMP = WS_XRES + (size_t)M * D * 2;
constexpr size_t WS_H = 852 * MiB;
constexpr size_t WS_ACT = 918 * MiB;
constexpr size_t WS_U = 918 * MiB, WS_GU = 951 * MiB, WS_GV = 984 * MiB, WS_GS = 1017 * MiB, WS_GG = 1083 * MiB, WS_Y = 1149 * MiB, WS_S2 = 1182 * MiB, WS_T = 1215 * MiB;
constexpr size_t WS_PART = 1281 * MiB;
constexpr int NSPLIT = 16;
constexpr size_t WS_PARTW = 1313 * MiB;
constexpr int NSPLITW = 4;
constexpr size_t WS_PARTG = 1343 * MiB;
constexpr int NSPLITG = 4;
constexpr size_t WS_PARTU = 790 * MiB;
constexpr int NSPLITU = 8;
static_assert(WS_XSAMP + (size_t)NSAMP * D * 4 <= WS_PARTU && WS_PARTU + (size_t)NSPLITU * NSAMP * 2 * D * 4 <= 852 * MiB, "ws map 5");
constexpr size_t WS_END = 1352 * MiB;
static_assert(WS_E + (size_t)NB * NCH * NGRP * NST * 8 <= WS_WGU1 && WS_WGU1 + (size_t)2 * DFF * D * 2 <= WS_WD1 && WS_WD1 + (size_t)D * DFF * 2 <= WS_WIN && WS_WIN + (size_t)INW * D * 2 <= WS_WGLU, "ws map 1");
static_assert(WS_WGLU + (size_t)2 * D * SW * 2 <= WS_WGOUT && WS_WGOUT + (size_t)D * GW * 2 <= WS_WOUT && WS_WOUT + (size_t)D * D * 2 <= WS_WGU2 && WS_WGU2 + (size_t)2 * DFF * D * 2 <= WS_WD2 && WS_WD2 + (size_t)D * DFF * 2 <= WS_XRES, "ws map 2");
static_assert(WS_XRES + (size_t)M * D * 4 <= WS_H && WS_H + (size_t)M * D * 2 <= WS_ACT && WS_ACT + (size_t)M * DFF * 2 <= WS_PART, "ws map 3");
static_assert(WS_U + (size_t)M * SW * 2 <= WS_GU && WS_GU + (size_t)M * GW * 2 <= WS_GV && WS_GV + (size_t)M * GW * 2 <= WS_GS && WS_GS + (size_t)M * D * 2 <= WS_GG && WS_GG + (size_t)M * D * 2 <= WS_Y &&
              WS_Y + (size_t)M * SW * 2 <= WS_S2 && WS_S2 + (size_t)M * GW * 2 <= WS_T && WS_T + (size_t)M * D * 2 <= WS_PART && WS_PART + (size_t)NSPLIT * NSAMP * D * 4 <= WS_PARTW && WS_PARTW + (size_t)NSPLITW * NSAMP * INW * 4 <= WS_PARTG && WS_PARTG + (size_t)NSPLITG * NSAMP * D * 4 <= WS_END, "ws map 4");
#ifndef MK_GATE_G0
#define MK_GATE_G0 7
#endif
#ifndef MK_GATE_SG
#define MK_GATE_SG 7
#endif
constexpr int GATE_G0 = MK_GATE_G0, GATE_SG = MK_GATE_SG;
constexpr int NPN1 = 2 * 11008 / 256;
constexpr int CW_GATE2 = 96;
constexpr int CW_GATE = 64;
constexpr int CW_BAR = 4096;

constexpr int RING_OFF = 0, RING_BYTES = 131072;
constexpr int LDSCTL_OFF = RING_BYTES, MISC_OFF = LDSCTL_OFF + 320;
constexpr int LDS_BYTES = 147456;
static_assert(MISC_OFF + 128 <= LDS_BYTES, "LDS map");
static_assert((CW_BAR + 3456) * 4 <= (int)CTL_ZERO_BYTES, "barrier words inside the per-call memset");

#define GAS __attribute__((address_space(1)))
#define LAS __attribute__((address_space(3)))
typedef unsigned short bf16;
typedef unsigned v4u __attribute__((ext_vector_type(4)));
typedef unsigned v2u __attribute__((ext_vector_type(2)));
typedef float f32x4 __attribute__((ext_vector_type(4)));
typedef float f32x2 __attribute__((ext_vector_type(2)));
typedef short bf16x8 __attribute__((ext_vector_type(8)));
typedef GAS unsigned gu32;
#define RLX_AGENT __ATOMIC_RELAXED, __HIP_MEMORY_SCOPE_AGENT
#define LDS_WAIT() asm volatile("s_waitcnt lgkmcnt(0)" ::: "memory")
using pg8::cvt_pk_bf16; using pg8::bflo; using pg8::bfhi; using pg8::fgelu; using pg8::fsigmoid;

#define XB_TMO      128
#define XB_XCNT(j)  (256  + 64 * (j))
#define XB_XSUB(j)  (1280 + 64 * (j))
#define XB_XGEN(j)  (2304 + 64 * (j))
#define XB_TOP      3328
#define XB_TOPGEN   3392
#define XCD_BAR_WORDS 3456
#define XB_SPIN_CAP (1u << 18)
__device__ __forceinline__ unsigned xb_ld(unsigned* p)              { return __hip_atomic_load(p, __ATOMIC_RELAXED, __HIP_MEMORY_SCOPE_AGENT); }
__device__ __forceinline__ unsigned xb_add(unsigned* p, unsigned v) { return __hip_atomic_fetch_add(p, v, __ATOMIC_RELAXED, __HIP_MEMORY_SCOPE_AGENT); }
__device__ __forceinline__ unsigned xb_xcc_id() { return (unsigned)__builtin_amdgcn_s_getreg((3 << 11) | 20) & 0xFu; }
#define XB_SPIN(cond, bar) do { unsigned _sp = 0; while (cond) { __builtin_amdgcn_s_sleep(1); \
    if ((++_sp & 255u) == 0u) { if (xb_ld(&(bar)[XB_TMO])) break; if (_sp > XB_SPIN_CAP) { atomicAdd(&(bar)[XB_TMO], 1u); break; } } } } while (0)
struct XcdBarrier { unsigned* bar; unsigned x; volatile LAS unsigned* st; };
__device__ __forceinline__ XcdBarrier xcd_barrier_post(unsigned* bar, volatile LAS unsigned* st) {
    XcdBarrier b; b.bar = bar; b.x = xb_xcc_id(); b.st = st;
    if (threadIdx.x == 0) (void)xb_add(&bar[XB_XCNT(b.x)], 1u);
    return b;
}
__device__ __forceinline__ void xcd_barrier_complete(unsigned* bar, unsigned x, unsigned& nloc, unsigned& nx) {
    const unsigned G = gridDim.x * gridDim.y * gridDim.z;
    unsigned sum, cnt, mine, sp = 0u;
    for (;;) {
        sum = 0u; cnt = 0u; mine = 0u;
#pragma unroll
        for (unsigned j = 0; j < 16; ++j) { const unsigned c = xb_ld(&bar[XB_XCNT(j)]); sum += c; cnt += (c > 0u) ? 1u : 0u; mine = (j == x) ? c : mine; }
        if (sum == G) break;
        __builtin_amdgcn_s_sleep(1);
        if ((++sp & 255u) == 0u) { if (xb_ld(&bar[XB_TMO])) break; if (sp > XB_SPIN_CAP) { atomicAdd(&bar[XB_TMO], 1u); break; } }
    }
    nloc = mine > 0u ? mine : 1u; nx = cnt > 0u ? cnt : 1u;
}
__device__ __forceinline__ void xcd_barrier(const XcdBarrier& b) {
    asm volatile("s_waitcnt vmcnt(0)" ::: "memory");
    __syncthreads();
    if (threadIdx.x == 0) {
        unsigned* bar = b.bar;
        __builtin_amdgcn_s_waitcnt(0);
        unsigned nloc = b.st[0], nx = b.st[1];
        if (nloc == 0u) { xcd_barrier_complete(bar, b.x, nloc, nx); b.st[0] = nloc; b.st[1] = nx; }
        const unsigned old = xb_add(&bar[XB_XSUB(b.x)], 1u);
        const unsigned gen = old / nloc;
        if (old + 1u == (gen + 1u) * nloc) {
            __builtin_amdgcn_fence(__ATOMIC_RELEASE, "agent");
            asm volatile("s_waitcnt vmcnt(0)" ::: "memory");
            const unsigned og = xb_add(&bar[XB_TOP], 1u);
            const unsigned tg = og / nx;
            if (og + 1u == (tg + 1u) * nx) xb_add(&bar[XB_TOPGEN], 1u);
            else XB_SPIN(xb_ld(&bar[XB_TOPGEN]) == tg, bar);
            __builtin_amdgcn_fence(__ATOMIC_ACQUIRE, "agent");
            xb_add(&bar[XB_XGEN(b.x)], 1u);
            asm volatile("s_waitcnt vmcnt(0)" ::: "memory");
        } else {
            XB_SPIN(xb_ld(&bar[XB_XGEN(b.x)]) == gen, bar);
            __builtin_amdgcn_fence(__ATOMIC_ACQUIRE, "agent");
            asm volatile("s_waitcnt vmcnt(0)" ::: "memory");
        }
    }
    __syncthreads();
}

struct Args { const float* in[29]; float* out; unsigned char* ws; int ph_lo, ph_hi; };
struct Frame {
    LAS unsigned char* lds;
    int tid, lane, wave, gw, ngw;
    unsigned char* ws; float* out;
};
__device__ __forceinline__ float wave_sum(float v) {
#pragma unroll
    for (int o = 1; o < 64; o <<= 1) v += __shfl_xor(v, o);
    return v;
}

__device__ __forceinline__ int map_row(int n, int mode) {
    if (mode == 0) return n;
    if (mode == 3) { const int h = n >= D ? 1 : 0, n2 = n - h * D; return 256 * (n2 >> 7) + 128 * h + (n2 & 127); }
    return 256 * (n >> 7) + 128 * (mode - 1) + (n & 127);
}
__device__ __forceinline__ void p0_item_load(const float* __restrict__ W, int N, int nblk, int nb0, int item, int lane, f32x4 (&v)[8]) {
    const int kb = item / nblk, nb = nb0 + item % nblk;
    const float* src = W + (size_t)(64 * kb + (lane >> 3)) * N + 32 * nb + 4 * (lane & 7);
#pragma unroll
    for (int i = 0; i < 8; ++i) v[i] = __builtin_nontemporal_load((const f32x4*)(src + (size_t)(8 * i) * N));
}
__device__ __forceinline__ void p0_item_store(const f32x4 (&v)[8], int K, int nblk, int nb0, bf16* __restrict__ WT, int mode, LAS float* scr, int item, int lane) {
    const int kb = item / nblk, nb = nb0 + item % nblk, k0 = 64 * kb, n0 = 32 * nb;
#pragma unroll
    for (int i = 0; i < 8; ++i) { LAS float* d = scr + (8 * i + (lane >> 3)) * 33 + 4 * (lane & 7); d[0] = v[i].x; d[1] = v[i].y; d[2] = v[i].z; d[3] = v[i].w; }
    LDS_WAIT(); asm volatile("" ::: "memory");
    const int c = lane & 7, r0 = map_row(n0, mode);
    const float wsc = mode == 1 ? 1.44269504089f : (mode == 2 ? 0.69314718056f : 1.0f);
#pragma unroll
    for (int j = 0; j < 4; ++j) { const int n = (lane >> 3) + 8 * j; const LAS float* s = scr + (8 * c) * 33 + n;
        v4u o; o.x = cvt_pk_bf16(s[0 * 33] * wsc, s[1 * 33] * wsc); o.y = cvt_pk_bf16(s[2 * 33] * wsc, s[3 * 33] * wsc); o.z = cvt_pk_bf16(s[4 * 33] * wsc, s[5 * 33] * wsc); o.w = cvt_pk_bf16(s[6 * 33] * wsc, s[7 * 33] * wsc);
        *(v4u*)(WT + (size_t)(r0 + n) * K + k0 + 8 * c) = o; }
    LDS_WAIT(); asm volatile("" ::: "memory");
}
__device__ __forceinline__ void p0_transpose(Frame& F, const float* W, int K, int N, bf16* WT, int mode, int w0, int nw, int f0 = 0, int f1 = 16, int nb0 = 0, int nbn = 0) {
    LAS float* scr = (LAS float*)(F.lds + RING_OFF + F.wave * 16384);
    const int nblk = nbn ? nbn : N / 32, nall = (K / 64) * nblk, nitems = (int)((long)nall * f1 / 16);
    int it = (int)((long)nall * f0 / 16) + w0; if (it >= nitems) return;
    f32x4 va[8], vb[8], vc[8];
    __builtin_amdgcn_s_waitcnt(0x0F70);
    const int last = nitems - 1, ntri = ((nitems - it + nw - 1) / nw + 2) / 3;
    int i1 = min(it + nw, last);
    p0_item_load(W, N, nblk, nb0, it, F.lane, va);
    p0_item_load(W, N, nblk, nb0, i1, F.lane, vb); __builtin_amdgcn_sched_barrier(0);
    for (int p = 0; p < ntri; ++p) {
        const int i2 = min(i1 + nw, last), i3 = min(i2 + nw, last), i4 = min(i3 + nw, last);
        p0_item_load(W, N, nblk, nb0, i2, F.lane, vc); __builtin_amdgcn_sched_barrier(0);
        p0_item_store(va, K, nblk, nb0, WT, mode, scr, it, F.lane); __builtin_amdgcn_sched_barrier(0);
        p0_item_load(W, N, nblk, nb0, i3, F.lane, va); __builtin_amdgcn_sched_barrier(0);
        p0_item_store(vb, K, nblk, nb0, WT, mode, scr, i1, F.lane); __builtin_amdgcn_sched_barrier(0);
        p0_item_load(W, N, nblk, nb0, i4, F.lane, vb); __builtin_amdgcn_sched_barrier(0);
        p0_item_store(vc, K, nblk, nb0, WT, mode, scr, i2, F.lane); __builtin_amdgcn_sched_barrier(0);
        it = i3; i1 = i4;
    }
}
__device__ __forceinline__ void load_gain(const float* gain, int lane, f32x4 (&gn)[16]) {
#pragma unroll
    for (int j = 0; j < 16; ++j) gn[j] = ((const f32x4*)gain + lane)[64 * j];
}
template <bool COPY> __device__ __forceinline__ void rms_row_bf16(const float* xrow, const f32x4 (&gn)[16], bf16* orow, float* xcopy, int lane) {
    const f32x4* xr = (const f32x4*)xrow + lane;
    f32x4 v[16]; float s = 0.f;
#pragma unroll
    for (int j = 0; j < 16; ++j) { v[j] = xr[64 * j]; s += (v[j].x * v[j].x + v[j].y * v[j].y) + (v[j].z * v[j].z + v[j].w * v[j].w); }
    if (COPY) {
#pragma unroll
        for (int j = 0; j < 16; ++j) ((f32x4*)xcopy + lane)[64 * j] = v[j]; }
    const float r = 1.0f / sqrtf(wave_sum(s) * (1.0f / D) + EPS);
    v2u* o8 = (v2u*)orow + lane;
#pragma unroll
    for (int j = 0; j < 16; ++j) { const f32x4 g = gn[j]; v2u w; w.x = cvt_pk_bf16(v[j].x * r * g.x, v[j].y * r * g.y); w.y = cvt_pk_bf16(v[j].z * r * g.z, v[j].w * r * g.w); o8[64 * j] = w; }
}
__device__ __forceinline__ void rms_row_f32(const float* xrow, const f32x4 (&gn)[16], float* orow, int lane) {
    const f32x4* xr = (const f32x4*)xrow + lane;
    f32x4 v[16]; float s = 0.f;
#pragma unroll
    for (int j = 0; j < 16; ++j) { v[j] = xr[64 * j]; s += (v[j].x * v[j].x + v[j].y * v[j].y) + (v[j].z * v[j].z + v[j].w * v[j].w); }
    const float r = 1.0f / sqrtf(wave_sum(s) * (1.0f / D) + EPS);
#pragma unroll
    for (int j = 0; j < 16; ++j) ((f32x4*)orow + lane)[64 * j] = v[j] * r * gn[j];
}
__device__ __forceinline__ double dexp(double x) {
    const double kf = __builtin_rint(x * 1.4426950408889634); const double r = x - kf * 0.6931471805599453094;
    double p = 1.0 / 6227020800.0;
    p = p * r + 1.0 / 479001600.0; p = p * r + 1.0 / 39916800.0; p = p * r + 1.0 / 3628800.0; p = p * r + 1.0 / 362880.0; p = p * r + 1.0 / 40320.0; p = p * r + 1.0 / 5040.0;
    p = p * r + 1.0 / 720.0; p = p * r + 1.0 / 120.0; p = p * r + 1.0 / 24.0; p = p * r + 1.0 / 6.0; p = p * r + 0.5; p = p * r + 1.0; p = p * r + 1.0;
    const long long k = (long long)kf; const double sc = __longlong_as_double((k + 1023ll) << 52);
    return p * sc;
}
__device__ __forceinline__ void dsincos(double th, double& s, double& c) {
    const double qf = __builtin_rint(th * 0.63661977236758134308); const double r = (th - qf * 1.57079632679489655800) - qf * 6.123233995736766036e-17;
    const double r2 = r * r;
    double ps = -1.0 / 1307674368000.0; ps = ps * r2 + 1.0 / 6227020800.0; ps = ps * r2 - 1.0 / 39916800.0; ps = ps * r2 + 1.0 / 362880.0; ps = ps * r2 - 1.0 / 5040.0; ps = ps * r2 + 1.0 / 120.0; ps = ps * r2 - 1.0 / 6.0; ps = ps * r2 + 1.0; ps = ps * r;
    double pc = 1.0 / 20922789888000.0; pc = pc * r2 - 1.0 / 87178291200.0; pc = pc * r2 + 1.0 / 479001600.0; pc = pc * r2 - 1.0 / 3628800.0; pc = pc * r2 + 1.0 / 40320.0; pc = pc * r2 - 1.0 / 720.0; pc = pc * r2 + 1.0 / 24.0; pc = pc * r2 - 0.5; pc = pc * r2 + 1.0;
    const int q = (int)((long long)qf & 3ll);
    s = (q == 0) ? ps : (q == 1) ? pc : (q == 2) ? -ps : -pc;
    c = (q == 0) ? pc : (q == 1) ? -ps : (q == 2) ? -pc : ps;
}

__device__ __forceinline__ void ssm_discretise(Frame& F, const Args& A, int gt) {
    if (gt < NGRP * NST) {
        const int g = gt >> 6;
        const f32x4* bre4 = (const f32x4*)(A.in[13] + (size_t)gt * GCH); const f32x4* bim4 = (const f32x4*)(A.in[14] + (size_t)gt * GCH);
        f32x4 br4[4], bi4[4];
#pragma unroll
        for (int q = 0; q < 4; ++q) { br4[q] = bre4[q]; bi4[q] = bim4[q]; }
        const double lre = (double)A.in[10][gt], lim = (double)A.in[11][gt], dt = dexp((double)A.in[12][g]);
        const double mag = dexp(dt * lre); double sn, cs; dsincos(dt * lim, sn, cs);
        const double are = mag * cs, aim = mag * sn;
        const double magT = dexp((double)TCH * dt * lre); double snT, csT; dsincos((double)TCH * dt * lim, snT, csT);
        ((f32x2*)(F.ws + WS_ABAR))[gt] = (f32x2){(float)are, (float)aim};
        ((f32x2*)(F.ws + WS_AT))[gt] = (f32x2){(float)(magT * csT), (float)(magT * snT)};
        const double nr = are - 1.0, ni = aim, den = lre * lre + lim * lim;
        const double cre = (nr * lre + ni * lim) / den, cim = (ni * lre - nr * lim) / den;
        f32x4* bb4 = (f32x4*)((float*)(F.ws + WS_BB) + (size_t)gt * 32);
#pragma unroll
        for (int q = 0; q < 4; ++q) { f32x4 o_re, o_im;
#pragma unroll
            for (int j = 0; j < 4; ++j) { const double br = (double)br4[q][j], bi = (double)bi4[q][j]; o_re[j] = (float)(cre * br - cim * bi); o_im[j] = (float)(cre * bi + cim * br); }
            bb4[q] = o_re; bb4[4 + q] = o_im; }
    }
}
__device__ __forceinline__ void p0_prologue(Frame& F, const Args& A) {
    bf16* const wsb = (bf16*)F.ws;
    { f32x4 gn[16]; load_gain(A.in[4], F.lane, gn);
    for (int m = F.gw; m < M; m += F.ngw) {
        bf16* hr = (bf16*)(F.ws + WS_H) + (size_t)m * D;
        if (m < MREAL) { const float* src = m < NPROMPT ? A.in[0] + (size_t)m * D : A.in[1] + (size_t)(m - NPROMPT) * D; rms_row_bf16<false>(src, gn, hr, nullptr, F.lane); }
        else {
#pragma unroll
            for (int j = 0; j < 16; ++j) ((v2u*)hr + F.lane)[64 * j] = (v2u){0u, 0u};
            v4u z = (v4u){0u, 0u, 0u, 0u};
#pragma unroll
            for (int j = 0; j < 4; ++j) { ((v4u*)((bf16*)(F.ws + WS_Y) + (size_t)m * SW) + F.lane)[64 * j] = z; ((v4u*)((bf16*)(F.ws + WS_S2) + (size_t)m * GW) + F.lane)[64 * j] = z; }
        }
    } }
    p0_transpose(F, A.in[5], D, DFF, (bf16*)(F.ws + WS_WGU1), 1, F.gw, F.ngw, 0, 16, 0, 4 * GATE_G0);
    p0_transpose(F, A.in[6], D, DFF, (bf16*)(F.ws + WS_WGU1), 2, F.gw, F.ngw, 0, 16, 0, 4 * GATE_G0);
    p0_transpose(F, A.in[26], D, DFF, (bf16*)(F.ws + WS_WGU2), 2, F.gw, F.ngw, UP2_SPLIT, 16);
    (void)wsb;
}
__device__ __forceinline__ void convert_beside_ffn1(Frame& F, const Args& A, int w0, int nw) {
#pragma unroll 1
    for (int t0 = GATE_G0; t0 < NPN1; t0 += GATE_SG) { const int tn = min(GATE_SG, NPN1 - t0);
        p0_transpose(F, A.in[5], D, DFF, (bf16*)(F.ws + WS_WGU1), 1, w0, nw, 0, 16, 4 * t0, 4 * tn);
        p0_transpose(F, A.in[6], D, DFF, (bf16*)(F.ws + WS_WGU1), 2, w0, nw, 0, 16, 4 * t0, 4 * tn);
        __syncthreads();
        if (F.tid == 0) { __threadfence(); __hip_atomic_fetch_add((unsigned*)(F.ws + WS_CTL) + CW_GATE, 1u, __ATOMIC_RELEASE, __HIP_MEMORY_SCOPE_AGENT); }
    }
    p0_transpose(F, A.in[7], DFF, D, (bf16*)(F.ws + WS_WD1), 0, w0, nw);
    p0_transpose(F, A.in[9], D, INW, (bf16*)(F.ws + WS_WIN), 0, w0, nw);
    p0_transpose(F, A.in[22], GW, D, (bf16*)(F.ws + WS_WGOUT), 0, w0, nw);
}
__device__ __forceinline__ void convert_beside_ffn2(Frame& F, const Args& A, int w0, int nw) {
    p0_transpose(F, A.in[27], DFF, D, (bf16*)(F.ws + WS_WD2), 0, w0, nw);
}
__device__ __forceinline__ void convert_beside_win(Frame& F, const Args& A, int w0, int nw) {
    p0_transpose(F, A.in[25], D, DFF, (bf16*)(F.ws + WS_WGU2), 1, w0, nw);
    p0_transpose(F, A.in[26], D, DFF, (bf16*)(F.ws + WS_WGU2), 2, w0, nw, 0, UP2_SPLIT);
    p0_transpose(F, A.in[18], SW, 2 * D, (bf16*)(F.ws + WS_WGLU), 3, w0, nw);
    p0_transpose(F, A.in[23], D, D, (bf16*)(F.ws + WS_WOUT), 0, w0, nw);
}
template <bool FINAL> __device__ __forceinline__ void norm_sample_row(Frame& F, const float* gain, float scale, const float* samp_base, float* outf) {
    if ((int)blockIdx.x < NSAMP) {
        const int i = blockIdx.x, m = NPROMPT + i, col = 512 * F.wave + 4 * F.lane;
        float* xr = (float*)(F.ws + WS_XSAMP) + (size_t)i * D + col;
        const float* src = samp_base ? samp_base + (size_t)i * D + col : xr;
        f32x4 v0 = *(const f32x4*)src, v1 = *(const f32x4*)(src + 256);
        const float* pr = (const float*)(F.ws + WS_PART) + (size_t)i * D + col;
        f32x4 p0[NSPLIT], p1[NSPLIT];
#pragma unroll
        for (int ks = 0; ks < NSPLIT; ++ks) { p0[ks] = *(const f32x4*)(pr + (size_t)ks * NSAMP * D); p1[ks] = *(const f32x4*)(pr + (size_t)ks * NSAMP * D + 256); }
#pragma unroll
        for (int ks = 0; ks < NSPLIT; ++ks) { v0 = v0 + p0[ks] * scale; v1 = v1 + p1[ks] * scale; }
        if (!FINAL) { *(f32x4*)xr = v0; *(f32x4*)(xr + 256) = v1; }
        float sq = (v0.x * v0.x + v0.y * v0.y) + (v0.z * v0.z + v0.w * v0.w) + (v1.x * v1.x + v1.y * v1.y) + (v1.z * v1.z + v1.w * v1.w);
        sq = wave_sum(sq);
        LAS float* red = (LAS float*)(F.lds + RING_OFF);
        if (F.lane == 0) red[F.wave] = sq;
        __syncthreads();
        float tot = 0.f;
#pragma unroll
        for (int w = 0; w < NWAVES; ++w) tot += red[w];
        const float r = 1.0f / sqrtf(tot * (1.0f / D) + EPS);
        const f32x4 g0 = *(const f32x4*)(gain + col), g1 = *(const f32x4*)(gain + col + 256);
        if (FINAL) { *(f32x4*)(outf + (size_t)m * D + col) = v0 * r * g0; *(f32x4*)(outf + (size_t)m * D + col + 256) = v1 * r * g1; }
        else { bf16* hr = (bf16*)(F.ws + WS_H) + (size_t)m * D + col;
            v2u w0, w1; w0.x = cvt_pk_bf16(v0.x * r * g0.x, v0.y * r * g0.y); w0.y = cvt_pk_bf16(v0.z * r * g0.z, v0.w * r * g0.w); w1.x = cvt_pk_bf16(v1.x * r * g1.x, v1.y * r * g1.y); w1.y = cvt_pk_bf16(v1.z * r * g1.z, v1.w * r * g1.w);
            *(v2u*)hr = w0; *(v2u*)(hr + 256) = w1; }
        __syncthreads();
    }
}
__device__ __forceinline__ void load_gain8(const float* gain, int lane, f32x4 (&gn)[16]) {
#pragma unroll
    for (int j = 0; j < 8; ++j) { gn[2 * j] = *(const f32x4*)(gain + 8 * (64 * j + lane)); gn[2 * j + 1] = *(const f32x4*)(gain + 8 * (64 * j + lane) + 4); }
}
__device__ __forceinline__ void load_xrow(Frame& F, int m, f32x4 (&v)[16]) {
    const v4u* xr = (const v4u*)((const bf16*)(F.ws + WS_XRES) + (size_t)m * D) + F.lane;
    v4u w[8];
#pragma unroll
    for (int j = 0; j < 8; ++j) w[j] = xr[64 * j];
#pragma unroll
    for (int j = 0; j < 8; ++j) pg8::unpack8(w[j], v[2 * j], v[2 * j + 1]);
}
__device__ __forceinline__ float row_rnorm(const f32x4 (&v)[16]) {
    float s = 0.f;
#pragma unroll
    for (int j = 0; j < 16; ++j) s += (v[j].x * v[j].x + v[j].y * v[j].y) + (v[j].z * v[j].z + v[j].w * v[j].w);
    return 1.0f / sqrtf(wave_sum(s) * (1.0f / D) + EPS);
}
__device__ __forceinline__ void norm_phase(Frame& F, const float* gain, int nsplit, float scale, const float* samp_base) {
    (void)nsplit;
    norm_sample_row<false>(F, gain, scale, samp_base, nullptr);
    f32x4 gn[16]; load_gain8(gain, F.lane, gn);
    for (int m = F.gw; m < NPROMPT; m += F.ngw) {
        f32x4 v[16]; load_xrow(F, m, v);
        const float r = row_rnorm(v);
        v4u* o8 = (v4u*)((bf16*)(F.ws + WS_H) + (size_t)m * D) + F.lane;
#pragma unroll
        for (int j = 0; j < 8; ++j) o8[64 * j] = pg8::pack8(v[2 * j] * r * gn[2 * j], v[2 * j + 1] * r * gn[2 * j + 1]);
    }
}
__device__ __forceinline__ void final_norm_phase(Frame& F, const Args& A, int nsplit, float scale) {
    (void)nsplit;
    norm_sample_row<true>(F, A.in[28], scale, nullptr, F.out);
    f32x4 gn[16]; load_gain8(A.in[28], F.lane, gn);
    for (int m = F.gw; m < NPROMPT; m += F.ngw) {
        f32x4 v[16]; load_xrow(F, m, v);
        const float r = row_rnorm(v);
#pragma unroll
        for (int j = 0; j < 8; ++j) { f32x4* o = (f32x4*)(F.out + (size_t)m * D + 8 * (64 * j + F.lane)); o[0] = v[2 * j] * r * gn[2 * j]; o[1] = v[2 * j + 1] * r * gn[2 * j + 1]; }
    }
}

#define MFMA_PIN(a, b) do { __builtin_amdgcn_sched_barrier(0); asm volatile("" :: "v"(a), "v"(b)); } while (0)
#define MFMA_SETTLE() do { __builtin_amdgcn_sched_barrier(0); asm volatile("s_nop 15"); __builtin_amdgcn_sched_barrier(0); } while (0)
constexpr int BUP = 132, SSM_BU_BYTES = 16 * BUP * 4, SSM_LDS_W = SSM_BU_BYTES + 4352;
__device__ __forceinline__ void ssm_load_bfrag(Frame& F, int g, int lane, bf16x8 (&bf)[8]) {
    const int q = lane >> 4, hs = (q & 1) * 8; const bool lo = q >= 2;
#pragma unroll
    for (int cb = 0; cb < 8; ++cb) { const int col = 16 * cb + (lane & 15), p = col & 63, im = col >> 6;
        const float* src = (const float*)(F.ws + WS_BB) + (size_t)(g * NST + p) * 32 + im * 16 + hs;
        const f32x4 x0 = *(const f32x4*)src, x1 = *(const f32x4*)(src + 4);
        float v[8] = {x0.x, x0.y, x0.z, x0.w, x1.x, x1.y, x1.z, x1.w};
        unsigned w[4];
#pragma unroll
        for (int j = 0; j < 4; ++j) { const unsigned hi = cvt_pk_bf16(v[2 * j], v[2 * j + 1]);
            const unsigned l2 = cvt_pk_bf16(v[2 * j] - bflo(hi), v[2 * j + 1] - bfhi(hi)); w[j] = lo ? l2 : hi; }
        v4u ww = (v4u){w[0], w[1], w[2], w[3]}; bf[cb] = __builtin_bit_cast(bf16x8, ww); }
}
__device__ __forceinline__ bf16x8 ssm_load_afrag(const bf16* U, int row0, int g, int lane) {
    return *(const bf16x8*)(U + (size_t)(row0 + (lane & 15)) * SW + g * GCH + 8 * ((lane >> 4) & 1));
}
__device__ __forceinline__ void ssm_bu16(const bf16x8 afr, const bf16x8 (&bf)[8], LAS float* bubuf, int lane) {
    LAS float* wp = bubuf + (4 * (lane >> 4)) * BUP + (lane & 15);
    f32x4 d[8];
#pragma unroll
    for (int cb = 0; cb < 8; ++cb) { d[cb] = __builtin_amdgcn_mfma_f32_16x16x32_bf16(afr, bf[cb], (f32x4){0.f, 0.f, 0.f, 0.f}, 0, 0, 0); MFMA_PIN(afr, bf[cb]); }
    MFMA_SETTLE();
#pragma unroll
    for (int cb = 0; cb < 8; ++cb) { wp[16 * cb] = d[cb][0]; wp[16 * cb + BUP] = d[cb][1]; wp[16 * cb + 2 * BUP] = d[cb][2]; wp[16 * cb + 3 * BUP] = d[cb][3]; }
    LDS_WAIT(); asm volatile("" ::: "memory");
}
__device__ __forceinline__ void ssm_load_u(const bf16* U, int r0, int nrows, int g, LAS float* ubuf, int lane) {
    if (lane < nrows) { const v4u* p = (const v4u*)(U + (size_t)(r0 + lane) * SW + g * GCH); const v4u a = p[0], b = p[1];
        LAS f32x4* o = (LAS f32x4*)(ubuf + lane * 16);
        o[0] = (f32x4){bflo(a.x), bfhi(a.x), bflo(a.y), bfhi(a.y)}; o[1] = (f32x4){bflo(a.z), bfhi(a.z), bflo(a.w), bfhi(a.w)};
        o[2] = (f32x4){bflo(b.x), bfhi(b.x), bflo(b.y), bfhi(b.y)}; o[3] = (f32x4){bflo(b.z), bfhi(b.z), bflo(b.w), bfhi(b.w)}; }
    LDS_WAIT(); asm volatile("" ::: "memory");
}
__device__ __forceinline__ void ssm_bu(const LAS float* ubuf, int t, const float (&bbr)[16], const float (&bbi)[16], float& bur, float& bui) {
    const LAS f32x4* up = (const LAS f32x4*)(ubuf + t * 16);
    float r0 = 0.f, r1 = 0.f, i0 = 0.f, i1 = 0.f;
#pragma unroll
    for (int q = 0; q < 4; ++q) { const f32x4 u = up[q];
        r0 = fmaf(u.x, bbr[4 * q + 0], r0); r1 = fmaf(u.y, bbr[4 * q + 1], r1); r0 = fmaf(u.z, bbr[4 * q + 2], r0); r1 = fmaf(u.w, bbr[4 * q + 3], r1);
        i0 = fmaf(u.x, bbi[4 * q + 0], i0); i1 = fmaf(u.y, bbi[4 * q + 1], i1); i0 = fmaf(u.z, bbi[4 * q + 2], i0); i1 = fmaf(u.w, bbi[4 * q + 3], i1); }
    bur = r0 + r1; bui = i0 + i1;
}
__device__ __forceinline__ void ssm_load_bb(Frame& F, int g, int lane, float (&bbr)[16], float (&bbi)[16]) {
    const f32x4* p = (const f32x4*)((const float*)(F.ws + WS_BB) + (size_t)(g * NST + lane) * 32);
#pragma unroll
    for (int q = 0; q < 4; ++q) { const f32x4 a = p[q], b = p[4 + q]; bbr[4 * q] = a.x; bbr[4 * q + 1] = a.y; bbr[4 * q + 2] = a.z; bbr[4 * q + 3] = a.w; bbi[4 * q] = b.x; bbi[4 * q + 1] = b.y; bbi[4 * q + 2] = b.z; bbi[4 * q + 3] = b.w; }
}
__device__ __forceinline__ void p5_phase(Frame& F) {
    LAS float* bubuf = (LAS float*)(F.lds + RING_OFF + F.wave * SSM_LDS_W);
    const bf16* U = (const bf16*)(F.ws + WS_U);
    const int g = F.gw & (NGRP - 1);
    bf16x8 bf[8]; ssm_load_bfrag(F, g, F.lane, bf);
    const f32x2 ab = ((const f32x2*)(F.ws + WS_ABAR))[g * NST + F.lane];
    bf16x8 nfr[4];
    { const int bc = F.gw >> 7, r0 = (bc / NCH) * SEQ + (bc % NCH) * TCH;
#pragma unroll
      for (int sub = 0; sub < 4; ++sub) nfr[sub] = ssm_load_afrag(U, r0 + 16 * sub, g, F.lane); }
    for (int it = F.gw; it < NB * NCH * NGRP; it += F.ngw) {
        bf16x8 afr[4];
#pragma unroll
        for (int sub = 0; sub < 4; ++sub) afr[sub] = nfr[sub];
        if (it + F.ngw < NB * NCH * NGRP) { const int bc = (it + F.ngw) >> 7, r0 = (bc / NCH) * SEQ + (bc % NCH) * TCH;
#pragma unroll
            for (int sub = 0; sub < 4; ++sub) nfr[sub] = ssm_load_afrag(U, r0 + 16 * sub, g, F.lane); }
        float sr = 0.f, si = 0.f;
#pragma unroll
        for (int sub = 0; sub < 4; ++sub) {
            ssm_bu16(afr[sub], bf, bubuf, F.lane);
#pragma unroll
            for (int tt = 0; tt < 16; ++tt) { const float bur = bubuf[tt * BUP + F.lane], bui = bubuf[tt * BUP + 64 + F.lane];
                const float nr = fmaf(ab.x, sr, fmaf(-ab.y, si, bur)), ni = fmaf(ab.x, si, fmaf(ab.y, sr, bui)); sr = nr; si = ni; }
            LDS_WAIT(); asm volatile("" ::: "memory");
        }
        ((f32x2*)(F.ws + WS_E))[(size_t)it * NST + F.lane] = (f32x2){sr, si};
    }
    if (!(F.gw & 1) && (F.gw >> 1) < NSAMP * 7) { const int item = F.gw >> 1;
        const int i = item / 7, part = item % 7, R = NPROMPT + i;
        const float* pr = (const float*)(F.ws + WS_PARTW) + (size_t)i * INW + part * 2048;
        bf16* dst = part == 0 ? (bf16*)(F.ws + WS_U) + (size_t)R * SW : part == 1 ? (bf16*)(F.ws + WS_GU) + (size_t)R * GW : part == 2 ? (bf16*)(F.ws + WS_GV) + (size_t)R * GW :
                    part < 5 ? (bf16*)(F.ws + WS_GS) + (size_t)R * D + (part - 3) * 2048 : (bf16*)(F.ws + WS_GG) + (size_t)R * D + (part - 5) * 2048;
        float ssq = 0.f;
#pragma unroll
        for (int it = 0; it < 4; ++it) {
            const int c = it * 512 + F.lane * 8;
            f32x4 z0 = (f32x4){0.f, 0.f, 0.f, 0.f}, z1 = z0;
#pragma unroll
            for (int ks = 0; ks < NSPLITW; ++ks) { const float* p = pr + (size_t)ks * NSAMP * INW + c; z0 = z0 + *(const f32x4*)p; z1 = z1 + *(const f32x4*)(p + 4); }
            if (part == 1 || part == 2) {
#pragma unroll
                for (int j = 0; j < 4; ++j) { z0[j] = fgelu(z0[j]); z1[j] = fgelu(z1[j]); } }
            if (part >= 3) {
#pragma unroll
                for (int j = 0; j < 4; ++j) { z0[j] = fsigmoid(z0[j]); z1[j] = fsigmoid(z1[j]); } }
            const v4u w = pg8::pack8(z0, z1);
            const float a0 = bflo(w.x), a1 = bfhi(w.x), a2 = bflo(w.y), a3 = bfhi(w.y), a4 = bflo(w.z), a5 = bfhi(w.z), a6 = bflo(w.w), a7 = bfhi(w.w);
            ssq += (a0 * a0 + a1 * a1) + (a2 * a2 + a3 * a3) + (a4 * a4 + a5 * a5) + (a6 * a6 + a7 * a7);
            *(v4u*)(dst + c) = w;
        }
        if (part == 2) { ssq = wave_sum(ssq); if (F.lane == 0) ((float*)(F.ws + WS_RS))[R] = 1.0f / sqrtf(ssq * (1.0f / GW) + EPS); }
    }
    for (int m = F.gw; m < NPROMPT; m += F.ngw) {
        const v4u* p = (const v4u*)((const bf16*)(F.ws + WS_GV) + (size_t)m * GW) + F.lane; float s = 0.f;
#pragma unroll
        for (int j = 0; j < 4; ++j) { const v4u w = p[64 * j];
            const float a0 = bflo(w.x), a1 = bfhi(w.x), a2 = bflo(w.y), a3 = bfhi(w.y), a4 = bflo(w.z), a5 = bfhi(w.z), a6 = bflo(w.w), a7 = bfhi(w.w);
            s += (a0 * a0 + a1 * a1) + (a2 * a2 + a3 * a3) + (a4 * a4 + a5 * a5) + (a6 * a6 + a7 * a7); }
        s = wave_sum(s);
        if (F.lane == 0) ((float*)(F.ws + WS_RS))[m] = 1.0f / sqrtf(s * (1.0f / GW) + EPS);
    }
}
__device__ __forceinline__ void ssm_out16(const LAS bf16* sbuf, const float (&uv)[4], const bf16x8 (&cf)[4], float dskip, bf16* Yrow0  , int lane) {
    f32x4 acc = (f32x4){0.f, 0.f, 0.f, 0.f};
    const LAS bf16* ap = sbuf + (lane & 15) * 136 + 8 * (lane >> 4);
    bf16x8 a[4];
#pragma unroll
    for (int kk = 0; kk < 4; ++kk) a[kk] = *(const LAS bf16x8*)(ap + 32 * kk);
#pragma unroll
    for (int kk = 0; kk < 4; ++kk) { acc = __builtin_amdgcn_mfma_f32_16x16x32_bf16(a[kk], cf[kk], acc, 0, 0, 0); MFMA_PIN(a[kk], cf[kk]); }
    MFMA_SETTLE();
    const int h = lane & 15, tq = 4 * (lane >> 4);
#pragma unroll
    for (int r = 0; r < 4; ++r) { const float y = acc[r] + dskip * uv[r]; Yrow0[(size_t)(tq + r) * SW + h] = (bf16)(cvt_pk_bf16(fgelu(y), 0.f) & 0xffffu); }
}
__device__ __forceinline__ void ssm_load_c(Frame& F, const Args& A, int g, int lane, bf16x8 (&cf)[4], float& dskip) {
    const int h = lane & 15, kq = 8 * (lane >> 4);
#pragma unroll
    for (int kk = 0; kk < 4; ++kk) { const int k0 = 32 * kk + kq; const float* src = (k0 < 64 ? A.in[15] : A.in[16]) + ((size_t)(g * GCH + h) * NST + (k0 & 63)); const float sg = k0 < 64 ? 1.f : -1.f;
        const f32x4 a = *(const f32x4*)src, b = *(const f32x4*)(src + 4);
        const unsigned w0 = cvt_pk_bf16(sg * a.x, sg * a.y), w1 = cvt_pk_bf16(sg * a.z, sg * a.w), w2 = cvt_pk_bf16(sg * b.x, sg * b.y), w3 = cvt_pk_bf16(sg * b.z, sg * b.w);
        v4u w = (v4u){w0, w1, w2, w3}; cf[kk] = __builtin_bit_cast(bf16x8, w); }
    dskip = A.in[17][g * GCH + h];
}
__device__ __forceinline__ void ssm_put_s(LAS bf16* sbuf, int tt, int lane, float sr, float si) {
    const unsigned w = cvt_pk_bf16(sr, si); sbuf[tt * 136 + lane] = (bf16)(w & 0xffffu); sbuf[tt * 136 + 64 + lane] = (bf16)(w >> 16);
}
__device__ __forceinline__ void p6_ssm(Frame& F, const Args& A) {
    LAS float* bubuf = (LAS float*)(F.lds + RING_OFF + F.wave * SSM_LDS_W);
    LAS bf16* sbuf = (LAS bf16*)(F.lds + RING_OFF + F.wave * SSM_LDS_W + SSM_BU_BYTES);
    const bf16* U = (const bf16*)(F.ws + WS_U); bf16* Y = (bf16*)(F.ws + WS_Y);
    const int g = F.gw & (NGRP - 1);
    const f32x2 ab = ((const f32x2*)(F.ws + WS_ABAR))[g * NST + F.lane];
    bf16x8 cf[4]; float dskip; ssm_load_c(F, A, g, F.lane, cf, dskip);
    const f32x2 aT = ((const f32x2*)(F.ws + WS_AT))[g * NST + F.lane];
    {
    bf16x8 bf[8]; ssm_load_bfrag(F, g, F.lane, bf);
    bf16x8 nfr[4]; unsigned short nur[4][4];
#define P6_ITEM_R0(itv) ({ const int _bc = (itv) >> 7, _b = _bc / NCH, _ci = _bc % NCH; _b * SEQ + ((_b & 1) ? _ci : NCH - 1 - _ci) * TCH; })
#define P6_LOAD(r0v) do { _Pragma("unroll") for (int sub = 0; sub < 4; ++sub) { nfr[sub] = ssm_load_afrag(U, (r0v) + 16 * sub, g, F.lane); \
        _Pragma("unroll") for (int r = 0; r < 4; ++r) nur[sub][r] = U[(size_t)((r0v) + 16 * sub + 4 * (F.lane >> 4) + r) * SW + g * GCH + (F.lane & 15)]; } } while (0)
    { const int r0n = P6_ITEM_R0(F.gw); P6_LOAD(r0n); }
    for (int it = F.gw; it < NB * NCH * NGRP; it += F.ngw) {
        const int bc = it >> 7, b = bc / NCH, cidx = bc % NCH, c = (b & 1) ? cidx : NCH - 1 - cidx, r0 = b * SEQ + c * TCH;
        bf16x8 afr[4]; unsigned short ur[4][4];
#pragma unroll
        for (int sub = 0; sub < 4; ++sub) { afr[sub] = nfr[sub];
#pragma unroll
            for (int r = 0; r < 4; ++r) ur[sub][r] = nur[sub][r]; }
        if (it + F.ngw < NB * NCH * NGRP) { const int r0n = P6_ITEM_R0(it + F.ngw); P6_LOAD(r0n); }
        float sr = 0.f, si = 0.f;
        { const f32x2* E = (const f32x2*)(F.ws + WS_E) + ((size_t)(b * NCH) * NGRP + g) * NST + F.lane;
          for (int c0 = 0; c0 < c; c0 += 8) {
              f32x2 e[8];
#pragma unroll
              for (int k = 0; k < 8; ++k) e[k] = (c0 + k < c) ? E[(size_t)(c0 + k) * NGRP * NST] : (f32x2){0.f, 0.f};
#pragma unroll
              for (int k = 0; k < 8; ++k) if (c0 + k < c) { const float nr = fmaf(aT.x, sr, fmaf(-aT.y, si, e[k].x)), ni = fmaf(aT.x, si, fmaf(aT.y, sr, e[k].y)); sr = nr; si = ni; } } }
#pragma unroll
        for (int sub = 0; sub < 4; ++sub) {
            ssm_bu16(afr[sub], bf, bubuf, F.lane);
#pragma unroll
            for (int tt = 0; tt < 16; ++tt) { const float bur = bubuf[tt * BUP + F.lane], bui = bubuf[tt * BUP + 64 + F.lane];
                const float nr = fmaf(ab.x, sr, fmaf(-ab.y, si, bur)), ni = fmaf(ab.x, si, fmaf(ab.y, sr, bui)); sr = nr; si = ni;
                ssm_put_s(sbuf, tt, F.lane, sr, si); }
            LDS_WAIT(); asm volatile("" ::: "memory");
            float uv[4];
#pragma unroll
            for (int r = 0; r < 4; ++r) uv[r] = __uint_as_float(((unsigned)ur[sub][r]) << 16);
            ssm_out16(sbuf, uv, cf, dskip, Y + (size_t)(r0 + sub * 16) * SW + g * GCH, F.lane);
            LDS_WAIT(); asm volatile("" ::: "memory");
        }
        if (c == NCH - 1) { F.out[O_PRE + (size_t)(b * NGRP + g) * NST + F.lane] = sr; F.out[O_PIM + (size_t)(b * NGRP + g) * NST + F.lane] = si; }
    } }
    {
    float bbr[16], bbi[16]; ssm_load_bb(F, g, F.lane, bbr, bbi);
    if (((F.gw >> 7) & 1) == (g & 1)) {
        const int sb = F.gw >> 8, r0 = NPROMPT + sb * 16;
        ssm_load_u(U, r0, 16, g, bubuf, F.lane);
#pragma unroll 4
        for (int i = 0; i < 16; ++i) { const size_t so = (size_t)((sb * 16 + i) * NGRP + g) * NST + F.lane;
            const float s0r = A.in[2][so], s0i = A.in[3][so]; float bur, bui; ssm_bu(bubuf, i, bbr, bbi, bur, bui);
            const float nr = fmaf(ab.x, s0r, fmaf(-ab.y, s0i, bur)), ni = fmaf(ab.x, s0i, fmaf(ab.y, s0r, bui));
            F.out[O_SRE + so] = nr; F.out[O_SIM + so] = ni; ssm_put_s(sbuf, i, F.lane, nr, ni); }
        LDS_WAIT(); asm volatile("" ::: "memory");
        float uv[4];
#pragma unroll
        for (int r = 0; r < 4; ++r) uv[r] = bubuf[(4 * (F.lane >> 4) + r) * 16 + (F.lane & 15)];
        ssm_out16(sbuf, uv, cf, dskip, Y + (size_t)r0 * SW + g * GCH, F.lane);
        LDS_WAIT(); asm volatile("" ::: "memory");
    } }
}
constexpr int VLD = 132;
__device__ __forceinline__ void p6_gmlp(Frame& F, const Args& A) {
    LAS bf16* vt = (LAS bf16*)(F.lds + RING_OFF);
    const bf16* GVp = (const bf16*)(F.ws + WS_GV); const bf16* GUp = (const bf16*)(F.ws + WS_GU); bf16* S2 = (bf16*)(F.ws + WS_S2);
    const float* RS = (const float*)(F.ws + WS_RS); const float* gnv = A.in[19]; const float* Wsp = A.in[20]; const float* bsp = A.in[21];
    const int lane = F.lane, w = F.wave;
    const int tcol = 16 * w + (lane & 15), kq = 8 * (lane >> 4), nks = (w >> 1) + 1;
    for (int it = blockIdx.x; it < NB * (SEQ / CHUNK) * NHEAD; it += gridDim.x) {
        const int g = it & 15, bn = it >> 4, R0 = bn * CHUNK, C0 = g * HD;
        v4u raw[4]; float rs[4];
#pragma unroll
        for (int q = 0; q < 4; ++q) { const int idx = q * 512 + F.tid, s = idx >> 4, e8 = (idx & 15) * 8; raw[q] = *(const v4u*)(GVp + (size_t)(R0 + s) * GW + C0 + e8); rs[q] = RS[R0 + s]; }
        const int e8c = (F.tid & 15) * 8; const f32x4 g0 = *(const f32x4*)(gnv + C0 + e8c), g1 = *(const f32x4*)(gnv + C0 + e8c + 4);
        f32x4 wa[4], wb[4];
#pragma unroll
        for (int ks = 0; ks < 4; ++ks) if (ks < nks) { const float* wp = Wsp + ((size_t)(g * CHUNK + tcol) * CHUNK + 32 * ks + kq); wa[ks] = *(const f32x4*)wp; wb[ks] = *(const f32x4*)(wp + 4); }
        const size_t rowoff = (size_t)(R0 + tcol) * GW + C0 + 4 * (lane >> 4);
        v2u gu2[8];
#pragma unroll
        for (int m = 0; m < 8; ++m) gu2[m] = *(const v2u*)(GUp + rowoff + 16 * m);
        const float bias = bsp[g * CHUNK + tcol];
        __syncthreads();
#pragma unroll
        for (int q = 0; q < 4; ++q) { const int idx = q * 512 + F.tid, s = idx >> 4; const float r = rs[q]; const v4u rw = raw[q];
            v2u o0, o1; o0.x = cvt_pk_bf16(bflo(rw.x) * r * g0.x, bfhi(rw.x) * r * g0.y); o0.y = cvt_pk_bf16(bflo(rw.y) * r * g0.z, bfhi(rw.y) * r * g0.w);
            o1.x = cvt_pk_bf16(bflo(rw.z) * r * g1.x, bfhi(rw.z) * r * g1.y); o1.y = cvt_pk_bf16(bflo(rw.w) * r * g1.z, bfhi(rw.w) * r * g1.w);
            LAS v2u* d = (LAS v2u*)(vt + s * VLD + e8c); d[0] = o0; d[1] = o1; }
        __syncthreads();
        f32x4 acc[8];
#pragma unroll
        for (int m = 0; m < 8; ++m) acc[m] = (f32x4){0.f, 0.f, 0.f, 0.f};
#pragma unroll
        for (int ks = 0; ks < 4; ++ks) if (ks < nks) {
            const int s0 = 32 * ks + kq;
            float wv[8] = {wa[ks].x, wa[ks].y, wa[ks].z, wa[ks].w, wb[ks].x, wb[ks].y, wb[ks].z, wb[ks].w};
#pragma unroll
            for (int j = 0; j < 8; ++j) wv[j] = (s0 + j <= tcol) ? wv[j] : 0.f;
            v4u bw = (v4u){cvt_pk_bf16(wv[0], wv[1]), cvt_pk_bf16(wv[2], wv[3]), cvt_pk_bf16(wv[4], wv[5]), cvt_pk_bf16(wv[6], wv[7])}; const bf16x8 bfrag = __builtin_bit_cast(bf16x8, bw);
#pragma unroll
            for (int m = 0; m < 8; ++m) {
                const LAS bf16* ap = vt + s0 * VLD + 16 * m + (lane & 15);
                unsigned e0 = ap[0], e1 = ap[VLD], e2 = ap[2 * VLD], e3 = ap[3 * VLD], e4 = ap[4 * VLD], e5 = ap[5 * VLD], e6 = ap[6 * VLD], e7 = ap[7 * VLD];
                v4u aw = (v4u){e0 | (e1 << 16), e2 | (e3 << 16), e4 | (e5 << 16), e6 | (e7 << 16)}; const bf16x8 afrag = __builtin_bit_cast(bf16x8, aw);
                acc[m] = __builtin_amdgcn_mfma_f32_16x16x32_bf16(afrag, bfrag, acc[m], 0, 0, 0); MFMA_PIN(afrag, bfrag);
            }
        }
        MFMA_SETTLE();
#pragma unroll
        for (int m = 0; m < 8; ++m) { const v2u gw2 = gu2[m];
            v2u o; o.x = cvt_pk_bf16(bflo(gw2.x) * (acc[m][0] + bias), bfhi(gw2.x) * (acc[m][1] + bias)); o.y = cvt_pk_bf16(bflo(gw2.y) * (acc[m][2] + bias), bfhi(gw2.y) * (acc[m][3] + bias));
            *(v2u*)(S2 + rowoff + 16 * m) = o; }
    }
    __syncthreads();
    if ((F.gw & 15) == 0) { const int i = F.gw >> 4;
        const int R = NPROMPT + i; const float rs = RS[R];
#pragma unroll
        for (int j = 0; j < 4; ++j) { const int e8 = (j * 64 + lane) * 8, g = e8 >> 7;
            const v4u raw = *(const v4u*)(GVp + (size_t)R * GW + e8), gur = *(const v4u*)(GUp + (size_t)R * GW + e8);
            const f32x4 g0 = *(const f32x4*)(gnv + e8), g1 = *(const f32x4*)(gnv + e8 + 4);
            const f32x4 v0 = (f32x4){bflo(raw.x) * rs * g0.x, bfhi(raw.x) * rs * g0.y, bflo(raw.y) * rs * g0.z, bfhi(raw.y) * rs * g0.w};
            const f32x4 v1 = (f32x4){bflo(raw.z) * rs * g1.x, bfhi(raw.z) * rs * g1.y, bflo(raw.w) * rs * g1.z, bfhi(raw.w) * rs * g1.w};
            *(f32x4*)(F.out + O_V + (size_t)i * GW + e8) = v0; *(f32x4*)(F.out + O_V + (size_t)i * GW + e8 + 4) = v1;
            const float w00 = Wsp[(size_t)g * CHUNK * CHUNK], b0 = bsp[g * CHUNK];
            f32x4 u0, u1; pg8::unpack8(gur, u0, u1);
            *(v4u*)(S2 + (size_t)R * GW + e8) = pg8::pack8(u0 * (v0 * w00 + b0), u1 * (v1 * w00 + b0)); }
    }
}

__device__ __forceinline__ void glu_sample_finish(Frame& F) {
    if ((int)blockIdx.x < NSAMP) {
        const int i = blockIdx.x, c = 8 * F.tid, pn = c >> 7, cc = c & 127; const size_t R = NPROMPT + i;
        const float* pu = (const float*)(F.ws + WS_PARTU) + (size_t)i * (2 * D) + 256 * pn + cc;
        f32x4 a0 = (f32x4){0.f, 0.f, 0.f, 0.f}, a1 = a0, b0 = a0, b1 = a0, t0 = a0, t1 = a0;
#pragma unroll
        for (int ks = 0; ks < NSPLITU; ++ks) { const float* q = pu + (size_t)ks * NSAMP * 2 * D;
            a0 = a0 + *(const f32x4*)q; a1 = a1 + *(const f32x4*)(q + 4); b0 = b0 + *(const f32x4*)(q + 128); b1 = b1 + *(const f32x4*)(q + 132); }
        const float* pg = (const float*)(F.ws + WS_PARTG) + (size_t)i * D + c;
#pragma unroll
        for (int ks = 0; ks < NSPLITG; ++ks) { t0 = t0 + *(const f32x4*)(pg + (size_t)ks * NSAMP * D); t1 = t1 + *(const f32x4*)(pg + (size_t)ks * NSAMP * D + 4); }
        f32x4 g0, g1, q0, q1;
        pg8::unpack8(*(const v4u*)((const bf16*)(F.ws + WS_GS) + R * D + c), g0, g1); pg8::unpack8(*(const v4u*)((const bf16*)(F.ws + WS_GG) + R * D + c), q0, q1);
        f32x4 v0, v1;
#pragma unroll
        for (int j = 0; j < 4; ++j) { v0[j] = g0[j] * (a0[j] * pg8::fsigmoid(b0[j])) + q0[j] * t0[j]; v1[j] = g1[j] * (a1[j] * pg8::fsigmoid(b1[j])) + q1[j] * t1[j]; }
        *(v4u*)((bf16*)(F.ws + WS_H) + R * D + c) = pg8::pack8(v0, v1);
        __syncthreads();
        if (F.tid == 0) { __threadfence(); __hip_atomic_fetch_add((unsigned*)(F.ws + WS_CTL) + CW_GATE2, 1u, __ATOMIC_RELEASE, __HIP_MEMORY_SCOPE_AGENT); }
    }
}

__global__ void __launch_bounds__(NWAVES * 64, 2) mk_fwd(Args args) {
    extern __shared__ __attribute__((aligned(16))) unsigned char lds[];
    Frame F;
    F.lds = (LAS unsigned char*)lds;
    volatile LAS unsigned* MISC = (volatile LAS unsigned*)(F.lds + MISC_OFF);
    F.tid = threadIdx.x; F.lane = F.tid & 63; F.wave = __builtin_amdgcn_readfirstlane(F.tid >> 6);
    F.gw = blockIdx.x * NWAVES + F.wave; F.ngw = gridDim.x * NWAVES;
    F.ws = args.ws; F.out = args.out;
    gu32* ctl = (gu32*)(args.ws + WS_CTL);
    for (int u = F.tid; u < (LDS_BYTES - LDSCTL_OFF) / 4; u += NWAVES * 64) ((LAS unsigned*)(F.lds + LDSCTL_OFF))[u] = 0u;
    __syncthreads();
    XcdBarrier bar; bar.bar = (unsigned*)(ctl + CW_BAR); bar.x = 0; bar.st = nullptr;
    if (!MK_SPLIT) bar = xcd_barrier_post((unsigned*)(ctl + CW_BAR), MISC + 8);
#define GRID_BAR() do { if (!MK_SPLIT) xcd_barrier(bar); } while (0)
    const int lo = args.ph_lo, hi = args.ph_hi, G = gridDim.x, bx = blockIdx.x;
#ifndef PH_MASK
#define PH_MASK 0xffff
#endif
#ifndef DUP_MASK
#define DUP_MASK 0
#endif
#define NREP(k) (((DUP_MASK >> (k)) & 1) ? 2 : 1)
#define IN(k) (((PH_MASK >> (k)) & 1) && lo <= (k) && (k) < hi)
#define BOTH(k) (IN(k) && IN((k) + 1))
    bf16* const Hb = (bf16*)(args.ws + WS_H); bf16* const ACT = (bf16*)(args.ws + WS_ACT); bf16* const XR = (bf16*)(args.ws + WS_XRES);

    if (IN(0)) _Pragma("unroll") for (int rep = 0; rep < NREP(0); ++rep) { p0_prologue(F, args); if (BOTH(0)) GRID_BAR(); }
    if (IN(1)) _Pragma("unroll") for (int rep = 0; rep < NREP(1); ++rep) {
        if (bx < NG1) {
        pg8::Gemm g{Hb, (const bf16*)(args.ws + WS_WGU1), M, 2 * DFF, D}; pg8::SampleOrderGated S; S.init(2 * DFF, D, NG1, bx, 1);
        S.ctr = (const unsigned*)(args.ws + WS_CTL) + CW_GATE; S.nconv = (unsigned)(G - NG1); S.base = S.nconv * (unsigned)((NPN1 - GATE_G0 + GATE_SG - 1) / GATE_SG) * rep; S.g0 = GATE_G0; S.sg = GATE_SG; S.seen = 0;
        pg8::EpiSwiGLU E{ACT, DFF};
        pg8::gemm_phase<pg8::EpiSwiGLU, pg8::SampleOrderGated, PG8_ALIGN, PG8_SP2>(F.lds + RING_OFF, g, S, E);
        } else { convert_beside_ffn1(F, args, (bx - NG1) * NWAVES + F.wave, (G - NG1) * NWAVES); ssm_discretise(F, args, (bx - NG1) * (NWAVES * 64) + F.tid); }
        if (BOTH(1)) GRID_BAR();
    }
    if (IN(2)) _Pragma("unroll") for (int rep = 0; rep < NREP(2); ++rep) {
        pg8::Gemm g{ACT, (const bf16*)(args.ws + WS_WD1), M, D, DFF}; pg8::SampleOrder S; S.init(D, DFF, G, bx, NSPLIT);
        pg8::EpiRes E{XR, D, rep == 0 ? 0.5f : 0.0f, (float*)(args.ws + WS_PART), args.in[0]};
        pg8::gemm_phase<pg8::EpiRes, pg8::SampleOrder, PG8_ALIGN, PG8_SP2>(F.lds + RING_OFF, g, S, E);
        if (BOTH(2)) GRID_BAR();
    }
    if (IN(3)) _Pragma("unroll") for (int rep = 0; rep < NREP(3); ++rep) { norm_phase(F, args.in[8], NSPLIT, 0.5f, args.in[1]); if (BOTH(3)) GRID_BAR(); }
    if (IN(4)) _Pragma("unroll") for (int rep = 0; rep < NREP(4); ++rep) {
        if (bx < NG4) {
        pg8::Gemm g{Hb, (const bf16*)(args.ws + WS_WIN), M, INW, D}; pg8::SampleOrder S; S.init(INW, D, NG4, bx, NSPLITW);
        pg8::EpiWin E{(bf16*)(args.ws + WS_U), (WS_GU - WS_U) / 2, (WS_GV - WS_U) / 2, (WS_GS - WS_U) / 2, (WS_GG - WS_U) / 2, (float*)(args.ws + WS_PARTW)};
        pg8::gemm_phase<pg8::EpiWin, pg8::SampleOrder, PG8_ALIGN, PG8_SP2>(F.lds + RING_OFF, g, S, E);
        } else convert_beside_win(F, args, (bx - NG4) * NWAVES + F.wave, (G - NG4) * NWAVES);
        if (BOTH(4)) GRID_BAR();
    }
    if (IN(5)) _Pragma("unroll") for (int rep = 0; rep < NREP(5); ++rep) { p5_phase(F); if (BOTH(5)) GRID_BAR(); }
    if (IN(6)) _Pragma("unroll") for (int rep = 0; rep < NREP(6); ++rep) { p6_gmlp(F, args); p6_ssm(F, args); if (BOTH(6)) GRID_BAR(); }
    if (IN(7)) _Pragma("unroll") for (int rep = 0; rep < NREP(7); ++rep) {
        pg8::Gemm g{(const bf16*)(args.ws + WS_S2), (const bf16*)(args.ws + WS_WGOUT), M, D, GW}; pg8::SampleOrder S; S.init(D, GW, G, bx, NSPLITG);
        pg8::EpiGout E{(const bf16*)(args.ws + WS_GG), (bf16*)(args.ws + WS_T), D, (float*)(args.ws + WS_PARTG)};
        pg8::gemm_phase<pg8::EpiGout, pg8::SampleOrder, PG8_ALIGN, PG8_SP2>(F.lds + RING_OFF, g, S, E);
        if (BOTH(7)) GRID_BAR();
    }
    if (IN(8)) _Pragma("unroll") for (int rep = 0; rep < NREP(8); ++rep) {
        pg8::Gemm g{(const bf16*)(args.ws + WS_Y), (const bf16*)(args.ws + WS_WGLU), M, 2 * D, SW}; pg8::SampleOrder S; S.init(2 * D, SW, G, bx, NSPLITU);
        pg8::EpiGlu E{(const bf16*)(args.ws + WS_GS), (const bf16*)(args.ws + WS_T), Hb, D, (float*)(args.ws + WS_PARTU)};
        pg8::gemm_phase<pg8::EpiGlu, pg8::SampleOrder, PG8_ALIGN, PG8_SP2>(F.lds + RING_OFF, g, S, E);
        if (BOTH(8)) GRID_BAR();
    }
    if (IN(9)) _Pragma("unroll") for (int rep = 0; rep < NREP(9); ++rep) {
        glu_sample_finish(F);
        pg8::Gemm g{Hb, (const bf16*)(args.ws + WS_WOUT), M, D, D}; pg8::SampleOrderSampGate S; S.init(D, D, G, bx, NSPLIT);
        S.ctr = (const unsigned*)(args.ws + WS_CTL) + CW_GATE2; S.need = (unsigned)NSAMP * (rep + 1); S.open = false;
        pg8::EpiRes E{XR, D, rep == 0 ? 1.0f : 0.0f, (float*)(args.ws + WS_PART), nullptr};
        pg8::gemm_phase<pg8::EpiRes, pg8::SampleOrderSampGate, PG8_ALIGN, PG8_SP2>(F.lds + RING_OFF, g, S, E);
        if (BOTH(9)) GRID_BAR();
    }
    if (IN(10)) _Pragma("unroll") for (int rep = 0; rep < NREP(10); ++rep) { norm_phase(F, args.in[24], rep == 0 ? NSPLIT : 0, 1.0f, nullptr); if (BOTH(10)) GRID_BAR(); }
    if (IN(11)) _Pragma("unroll") for (int rep = 0; rep < NREP(11); ++rep) {
        if (bx < NG11) {
        pg8::Gemm g{Hb, (const bf16*)(args.ws + WS_WGU2), M, 2 * DFF, D}; pg8::SampleOrder S; S.init(2 * DFF, D, NG11, bx, 1);
        pg8::EpiSwiGLU E{ACT, DFF};
        pg8::gemm_phase<pg8::EpiSwiGLU, pg8::SampleOrder, PG8_ALIGN, PG8_SP2>(F.lds + RING_OFF, g, S, E);
        } else convert_beside_ffn2(F, args, (bx - NG11) * NWAVES + F.wave, (G - NG11) * NWAVES);
        if (BOTH(11)) GRID_BAR();
    }
    if (IN(12)) _Pragma("unroll") for (int rep = 0; rep < NREP(12); ++rep) {
        pg8::Gemm g{ACT, (const bf16*)(args.ws + WS_WD2), M, D, DFF}; pg8::SampleOrder S; S.init(D, DFF, G, bx, NSPLIT);
        pg8::EpiRes E{XR, D, rep == 0 ? 0.5f : 0.0f, (float*)(args.ws + WS_PART), nullptr};
        pg8::gemm_phase<pg8::EpiRes, pg8::SampleOrder, PG8_ALIGN, PG8_SP2>(F.lds + RING_OFF, g, S, E);
        if (BOTH(12)) GRID_BAR();
    }
    if (IN(13)) _Pragma("unroll") for (int rep = 0; rep < NREP(13); ++rep) { final_norm_phase(F, args, NSPLIT, 0.5f); }
#undef IN
#undef BOTH
}

extern "C" void kernel_launch(void* const* d_in, const int* in_sizes, int n_in, void* d_out, int out_size, void* d_ws, size_t ws_size, hipStream_t stream) {
    static int grid = 0;
    if (grid == 0) {
        if (n_in != 29 || (size_t)out_size != O_END || ws_size < WS_END) { fprintf(stderr, "kernel_launch: unexpected shapes (n_in %d, out %d, ws %zu); nothing launched\n", n_in, out_size, ws_size); grid = -1; return; }
        int dev = 0, cus = 0, per_cu = 0;
        if (hipGetDevice(&dev) != hipSuccess || hipDeviceGetAttribute(&cus, hipDeviceAttributeMultiprocessorCount, dev) != hipSuccess) { fprintf(stderr, "kernel_launch: device query failed\n"); grid = -1; return; }
        if (hipFuncSetAttribute((const void*)mk_fwd, hipFuncAttributeMaxDynamicSharedMemorySize, LDS_BYTES) != hipSuccess) { fprintf(stderr, "kernel_launch: hipFuncSetAttribute failed\n"); grid = -1; return; }
        if (hipOccupancyMaxActiveBlocksPerMultiprocessor(&per_cu, (const void*)mk_fwd, NWAVES * 64, LDS_BYTES) != hipSuccess || per_cu < 1) fprintf(stderr, "kernel_launch: note: occupancy query reports %d workgroups per CU\n", per_cu);
        (void)hipGetLastError();
        if (cus < 256) { fprintf(stderr, "kernel_launch: %d CUs; this build needs 256\n", cus); grid = -1; return; }
        grid = 256;
        if (grid % 16 != 0) { fprintf(stderr, "kernel_launch: grid %d is not a multiple of 16\n", grid); grid = -1; return; }
    }
    if (grid < 0) return;
    (void)in_sizes;
    if (hipMemsetAsync((char*)d_ws + WS_CTL, 0, CTL_ZERO_BYTES, stream) != hipSuccess) { fprintf(stderr, "kernel_launch: memset failed\n"); return; }
    Args a{};
    for (int i = 0; i < 29; ++i) a.in[i] = (const float*)d_in[i];
    a.out = (float*)d_out; a.ws = (unsigned char*)d_ws;
#if MK_SPLIT
    for (int p = 0; p < N_PHASES; ++p) { a.ph_lo = p; a.ph_hi = p + 1; hipLaunchKernelGGL(mk_fwd, dim3(grid), dim3(NWAVES * 64), LDS_BYTES, stream, a); }
#else
    a.ph_lo = 0; a.ph_hi = N_PHASES;
    hipLaunchKernelGGL(mk_fwd, dim3(grid), dim3(NWAVES * 64), LDS_BYTES, stream, a);
#endif
    const hipError_t le = hipPeekAtLastError();
    if (le != hipSuccess) fprintf(stderr, "kernel_launch: launch failed: %s\n", hipGetErrorName(le));
}
```

```cpp
#include <hip/hip_runtime.h>
#include <cstdio>
#include <cstdint>

#ifndef MK_SPLIT
#define MK_SPLIT 0
#endif

namespace pg8 {
#define PG8_LAS __attribute__((address_space(3)))
typedef unsigned short bf16_t;
typedef short bf16x8 __attribute__((ext_vector_type(8)));
typedef float f32x4 __attribute__((ext_vector_type(4)));
typedef unsigned u32x4 __attribute__((ext_vector_type(4)));
typedef unsigned u32x2 __attribute__((ext_vector_type(2)));
constexpr int BM = 256, BK = 64, HALF = 128, HTB = HALF * BK * 2  , STAGE_BYTES = 8 * HTB, NXCD = 8, WGM = 4;

__host__ __device__ __forceinline__ int lds_byte(int r, int c) { const int st = (r >> 4) * 2 + (c >> 5), rr = r & 15, cc = c & 31, ob = rr * 64 + cc * 2; return st * 1024 + (ob ^ (((ob >> 9) & 1) << 5)); }
__host__ __device__ __forceinline__ void stage_rc(int b, int& R, int& C) { const int st = b / 1024, sb = b % 1024, swz = sb ^ (((sb >> 9) & 1) << 5); R = (st >> 1) * 16 + swz / 64; C = (st & 1) * 32 + (swz % 64) / 2; }
__host__ __device__ __forceinline__ int perm32(int rho) { const int n = rho >> 4, i = rho & 15; return 8 * (i >> 2) + 4 * n + (i & 3); }

struct Unit { int pm, pn, kt0, nkt, flags; };
struct Gemm { const bf16_t* A; const bf16_t* Bt; int M, N, K; };

struct StaticOrder {
    int nM, nN, nwg, G, c;
    __host__ __device__ void init(int M, int N, int G_, int c_) { nM = M / BM; nN = N / BM; nwg = nM * nN; G = G_; c = c_; }
    __host__ __device__ bool next(int i, Unit& u) const {
        const long L = (long)i * G + c; if (L >= nwg) return false;
        int wgid = (int)L; { const int q = nwg / NXCD, r = nwg % NXCD, xcd = wgid % NXCD, off = wgid / NXCD; wgid = (xcd < r ? xcd * (q + 1) : r * (q + 1) + (xcd - r) * q) + off; }
        const int nig = WGM * nN, gid = wgid / nig, fm = gid * WGM, gsz = (nM - fm) < WGM ? (nM - fm) : WGM;
        u.pm = fm + ((wgid % nig) % gsz); u.pn = (wgid % nig) / gsz; return true;
    }
    __device__ __forceinline__ void a_ready(const Unit&) const {}
    __device__ __forceinline__ void done(const Unit&) const {}
};
struct SampleOrder {
    StaticOrder base; int fullcnt, sbase, sstride, nsamp, nN, nsplit, nkt;
    __device__ void init(int N, int K, int G, int c, int nsplit_) {
        base.init(32 * BM, N, G, c); nN = N / BM; nsplit = nsplit_; nkt = K / BK; nsamp = nN * nsplit;
        const int nfull = 32 * nN, R = nfull % G; fullcnt = nfull / G + (c < R ? 1 : 0);
        if (R > 0) { sbase = c - R; sstride = G - R; } else { sbase = c; sstride = G; }
    }
    __device__ bool next(int i, Unit& u) const {
        if (i < fullcnt) { base.next(i, u); u.kt0 = 0; u.nkt = nkt; u.flags = 0; return true; }
        if (sbase < 0) return false;
        const int s = sbase + (i - fullcnt) * sstride; if (s >= nsamp) return false;
        const int ks = s / nN, pairs = nkt >> 1, q = pairs / nsplit, r = pairs % nsplit;
        u.pm = 32; u.pn = s % nN; u.kt0 = 2 * (ks * q + (ks < r ? ks : r)); u.nkt = 2 * (q + (ks < r ? 1 : 0)); u.flags = 1 | (nsplit > 1 ? 2 : 0) | (ks << 8); return true;
    }
    __device__ __forceinline__ void a_ready(const Unit&) const {}
    __device__ __forceinline__ void done(const Unit&) const {}
};

struct SampleOrderGated : SampleOrder {
    const unsigned* ctr; unsigned nconv, base; int g0, sg; mutable unsigned seen;
    __device__ __forceinline__ void a_ready(const Unit& u) const {
        const unsigned need = base + (u.pn < g0 ? 0u : (unsigned)(1 + (u.pn - g0) / sg) * nconv);
        if (seen < need) {
            unsigned v;
            while ((v = __hip_atomic_load(ctr, __ATOMIC_RELAXED, __HIP_MEMORY_SCOPE_AGENT)) < need) __builtin_amdgcn_s_sleep(16);
            __builtin_amdgcn_fence(__ATOMIC_ACQUIRE, "workgroup");
            seen = v;
        }
    }
};

__device__ __forceinline__ unsigned cvt_pk_bf16(float lo, float hi) { unsigned r; asm volatile("v_cvt_pk_bf16_f32 %0, %1, %2" : "=v"(r) : "v"(lo), "v"(hi)); return r; }
__device__ __forceinline__ float bflo(unsigned w) { return __uint_as_float(w << 16); }
__device__ __forceinline__ float bfhi(unsigned w) { return __uint_as_float(w & 0xffff0000u); }
__device__ __forceinline__ float fsigmoid(float x) { return __builtin_amdgcn_rcpf(1.0f + __builtin_amdgcn_exp2f(-1.44269504089f * x)); }
__device__ __forceinline__ float fsilu(float x) { return x * fsigmoid(x); }
__device__ __forceinline__ float fgelu(float x) { const float u = x * (1.0f + 0.044715f * x * x); return x * fsigmoid(1.5957691216057308f * u); }
__device__ __forceinline__ u32x4 pack8(const f32x4 a, const f32x4 b) { u32x4 w; w.x = cvt_pk_bf16(a[0], a[1]); w.y = cvt_pk_bf16(a[2], a[3]); w.z = cvt_pk_bf16(b[0], b[1]); w.w = cvt_pk_bf16(b[2], b[3]); return w; }
__device__ __forceinline__ void unpack8(const u32x4 w, f32x4& a, f32x4& b) { a = (f32x4){bflo(w.x), bfhi(w.x), bflo(w.y), bfhi(w.y)}; b = (f32x4){bflo(w.z), bfhi(w.z), bflo(w.w), bfhi(w.w)}; }


struct EpiSwiGLU {
    static constexpr bool PERM = true, AFTER_DRAIN = false;
    bf16_t* O; int ldc;
    __device__ __forceinline__ void operator()(const f32x4 (&acc)[2][2][4][2], const Unit& u, int wr, int wc, int fr, int fq) const {
        const int row0 = u.pm * BM + wr * 64 + fr, col0 = u.pn * HALF + wc * 32 + 8 * fq; const bool half = u.flags & 1;
#pragma unroll
        for (int ai = 0; ai < 2; ++ai) { if (ai == 1 && half) continue;
#pragma unroll
            for (int m = 0; m < 4; ++m) { bf16_t* rowp = O + (size_t)(row0 + ai * HALF + m * 16) * ldc + col0;
                f32x4 v0, v1;
#pragma unroll
                for (int j = 0; j < 4; ++j) { const float g0 = acc[ai][0][m][0][j], g1 = acc[ai][0][m][1][j];
                    v0[j] = (g0 * acc[ai][1][m][0][j]) * __builtin_amdgcn_rcpf(1.0f + __builtin_amdgcn_exp2f(-g0)); v1[j] = (g1 * acc[ai][1][m][1][j]) * __builtin_amdgcn_rcpf(1.0f + __builtin_amdgcn_exp2f(-g1)); }
                *(u32x4*)rowp = pack8(v0, v1); } }
    }
};
struct EpiWin {
    static constexpr bool PERM = true, AFTER_DRAIN = false;
    bf16_t* Z0;
    size_t oGU, oGV, oGS, oGG; float* PARTW;
    __device__ __forceinline__ void operator()(const f32x4 (&acc)[2][2][4][2], const Unit& u, int wr, int wc, int fr, int fq) const {
        const int t = u.pn;
        if (u.flags & 2) {
            float* base = PARTW + ((size_t)(u.flags >> 8) * HALF + wr * 64 + fr) * 14336 + t * BM + wc * 32 + 8 * fq;
#pragma unroll
            for (int m = 0; m < 4; ++m) { float* rowp = base + (size_t)(m * 16) * 14336;
#pragma unroll
                for (int bj = 0; bj < 2; ++bj) { *(f32x4*)(rowp + bj * HALF) = acc[0][bj][m][0]; *(f32x4*)(rowp + bj * HALF + 4) = acc[0][bj][m][1]; } }
            return;
        }
        const int act = t < 8 ? 0 : (t < 24 ? 1 : 2);
        const int ldc = t < 24 ? 2048 : 4096;
        const int tl = t < 8 ? t : (t < 16 ? t - 8 : (t < 24 ? t - 16 : (t < 40 ? t - 24 : t - 40)));
        const size_t ob = t < 8 ? 0 : (t < 16 ? oGU : (t < 24 ? oGV : (t < 40 ? oGS : oGG)));
        const int row0 = u.pm * BM + wr * 64 + fr, col0 = tl * BM + wc * 32 + 8 * fq;
        bf16_t* base = Z0 + ob; const bool half = u.flags & 1;
#pragma unroll
        for (int ai = 0; ai < 2; ++ai) { if (ai == 1 && half) continue;
#pragma unroll
            for (int m = 0; m < 4; ++m) { bf16_t* rowp = base + (size_t)(row0 + ai * HALF + m * 16) * ldc + col0;
#pragma unroll
                for (int bj = 0; bj < 2; ++bj) { f32x4 v0 = acc[ai][bj][m][0], v1 = acc[ai][bj][m][1];
                    if (act == 2) {
#pragma unroll
                        for (int j = 0; j < 4; ++j) { v0[j] = __builtin_amdgcn_rcpf(1.0f + __builtin_amdgcn_exp2f(-1.44269504089f * v0[j])); v1[j] = __builtin_amdgcn_rcpf(1.0f + __builtin_amdgcn_exp2f(-1.44269504089f * v1[j])); }
                    } else if (act == 1) {
#pragma unroll
                        for (int j = 0; j < 4; ++j) { const float x0 = v0[j], x1 = v1[j];
                            v0[j] = x0 * __builtin_amdgcn_rcpf(1.0f + __builtin_amdgcn_exp2f(x0 * fmaf(x0 * x0, -0.10294324f, -2.30220820f)));
                            v1[j] = x1 * __builtin_amdgcn_rcpf(1.0f + __builtin_amdgcn_exp2f(x1 * fmaf(x1 * x1, -0.10294324f, -2.30220820f))); }
                    }
                    *(u32x4*)(rowp + bj * HALF) = pack8(v0, v1); } } }
    }
};
struct EpiGout {
    static constexpr bool PERM = true, AFTER_DRAIN = false;
    const bf16_t* GG; bf16_t* T; int ldc; float* PARTG;
    __device__ __forceinline__ void operator()(const f32x4 (&acc)[2][2][4][2], const Unit& u, int wr, int wc, int fr, int fq) const {
        const int row0 = u.pm * BM + wr * 64 + fr, col0 = u.pn * BM + wc * 32 + 8 * fq; const bool half = u.flags & 1;
        if (u.flags & 2) {
            float* base = PARTG + ((size_t)(u.flags >> 8) * HALF + wr * 64 + fr) * ldc + col0;
#pragma unroll
            for (int m = 0; m < 4; ++m) { float* rowp = base + (size_t)(m * 16) * ldc;
#pragma unroll
                for (int bj = 0; bj < 2; ++bj) { *(f32x4*)(rowp + bj * HALF) = acc[0][bj][m][0]; *(f32x4*)(rowp + bj * HALF + 4) = acc[0][bj][m][1]; } }
            return;
        }
#pragma unroll
        for (int ai = 0; ai < 2; ++ai) { if (ai == 1 && half) continue;
#pragma unroll
            for (int m = 0; m < 4; ++m) { const size_t off = (size_t)(row0 + ai * HALF + m * 16) * ldc + col0;
#pragma unroll
                for (int bj = 0; bj < 2; ++bj) { f32x4 g0, g1; unpack8(*(const u32x4*)(GG + off + bj * HALF), g0, g1);
                    *(u32x4*)(T + off + bj * HALF) = pack8(g0 * acc[ai][bj][m][0], g1 * acc[ai][bj][m][1]); } } }
    }
};
struct EpiGlu {
    static constexpr bool PERM = true, AFTER_DRAIN = false;
    const bf16_t* GS; const bf16_t* T; bf16_t* MG; int ldc; const bf16_t* GG; const float* PARTG;
    __device__ __forceinline__ void operator()(const f32x4 (&acc)[2][2][4][2], const Unit& u, int wr, int wc, int fr, int fq) const {
        const int row0 = u.pm * BM + wr * 64 + fr, col0 = u.pn * HALF + wc * 32 + 8 * fq; const bool half = u.flags & 1, samp = u.pm == 32;
#pragma unroll
        for (int ai = 0; ai < 2; ++ai) { if (ai == 1 && half) continue;
#pragma unroll
            for (int m = 0; m < 4; ++m) { const size_t off = (size_t)(row0 + ai * HALF + m * 16) * ldc + col0;
                f32x4 g0, g1, t0, t1; unpack8(*(const u32x4*)(GS + off), g0, g1);
                if (samp) { const float* pp = PARTG + (size_t)(wr * 64 + fr + m * 16) * ldc + col0; f32x4 s0 = (f32x4){0.f, 0.f, 0.f, 0.f}, s1 = s0;
#pragma unroll
                    for (int ks = 0; ks < 4; ++ks) { s0 = s0 + *(const f32x4*)(pp + (size_t)ks * HALF * ldc); s1 = s1 + *(const f32x4*)(pp + (size_t)ks * HALF * ldc + 4); }
                    f32x4 q0, q1; unpack8(*(const u32x4*)(GG + off), q0, q1); t0 = q0 * s0; t1 = q1 * s1; }
                else unpack8(*(const u32x4*)(T + off), t0, t1);
                f32x4 v0, v1;
#pragma unroll
                for (int j = 0; j < 4; ++j) { v0[j] = g0[j] * (acc[ai][0][m][0][j] * fsigmoid(acc[ai][1][m][0][j])) + t0[j]; v1[j] = g1[j] * (acc[ai][0][m][1][j] * fsigmoid(acc[ai][1][m][1][j])) + t1[j]; }
                *(u32x4*)(MG + off) = pack8(v0, v1); } }
    }
};
struct EpiRes {
    static constexpr bool PERM = true, AFTER_DRAIN = false;
    bf16_t* X; int ldc; float scale; float* PART; const float* Xp;
    __device__ __forceinline__ void operator()(const f32x4 (&acc)[2][2][4][2], const Unit& u, int wr, int wc, int fr, int fq) const {
        const int col0 = u.pn * BM + wc * 32 + 8 * fq;
        if (u.flags & 2) {
            float* base = PART + ((size_t)(u.flags >> 8) * HALF + wr * 64 + fr) * ldc + col0;
#pragma unroll
            for (int m = 0; m < 4; ++m) { float* rowp = base + (size_t)(m * 16) * ldc;
#pragma unroll
                for (int bj = 0; bj < 2; ++bj) { *(f32x4*)(rowp + bj * HALF) = acc[0][bj][m][0]; *(f32x4*)(rowp + bj * HALF + 4) = acc[0][bj][m][1]; } }
        } else {
            const int row0 = u.pm * BM + wr * 64 + fr; const bool half = u.flags & 1;
#pragma unroll
            for (int ai = 0; ai < 2; ++ai) { if (ai == 1 && half) continue;
#pragma unroll
                for (int m = 0; m < 4; ++m) { const size_t off = (size_t)(row0 + ai * HALF + m * 16) * ldc + col0;
#pragma unroll
                    for (int bj = 0; bj < 2; ++bj) { f32x4 x0, x1;
                        if (Xp) { x0 = *(const f32x4*)(Xp + off + bj * HALF); x1 = *(const f32x4*)(Xp + off + bj * HALF + 4); }
                        else unpack8(*(const u32x4*)(X + off + bj * HALF), x0, x1);
                        *(u32x4*)(X + off + bj * HALF) = pack8(x0 + acc[ai][bj][m][0] * scale, x1 + acc[ai][bj][m][1] * scale); } } }
        }
    }
};

template <class Epi, class Sched, bool ALIGN_EPI = false, bool SP2 = true>
__device__ __forceinline__ void gemm_phase(PG8_LAS unsigned char* lds, const Gemm g, const Sched& S, const Epi& E) {
    static_assert(SP2, "only the two-super-phase loop is kept");
    const int tid = threadIdx.x, wid = __builtin_amdgcn_readfirstlane(tid >> 6), lane = tid & 63, wr = wid >> 2, wc = wid & 3, fr = lane & 15, fq = lane >> 4;
    const int K = g.K;
    unsigned voffA[2], voffB[2];
#pragma unroll
    for (int i = 0; i < 2; ++i) { int R, C; stage_rc(tid * 16 + i * 8192, R, C); const int Rb = Epi::PERM ? ((R & ~31) + perm32(R & 31)) : R;
        voffA[i] = (unsigned)(R * K + C) * 2u; voffB[i] = (unsigned)(Rb * K + C) * 2u; }
    const size_t kstep = (size_t)(BK * 2);
    const size_t hstep = (size_t)HALF * K * 2;
    const size_t tstep = 2 * hstep;
    const unsigned ldsw = (unsigned)wid * 1024u;
    const int aoff = lds_byte(wr * 64 + fr, fq * 8), boff = lds_byte(wc * 32 + fr, fq * 8);
#define PG8_SA(b, h) (((b) * 2 + (h)) * HTB)
#define PG8_SB(b, h) ((4 + (b) * 2 + (h)) * HTB)
#define PG8_STAGE(bufoff, gbase, voff) do { _Pragma("unroll") for (int _i = 0; _i < 2; ++_i) \
        __builtin_amdgcn_global_load_lds((const unsigned*)((const char*)(gbase) + (voff)[_i]), (PG8_LAS unsigned*)(lds + (bufoff) + ldsw + _i * 8192), 16, 0, 0); } while (0)
#define PG8_LDA(dst, b, h) do { _Pragma("unroll") for (int m = 0; m < 4; ++m) _Pragma("unroll") for (int k = 0; k < 2; ++k) dst[m][k] = *(const PG8_LAS bf16x8*)(lds + PG8_SA(b, h) + aoff + m * 2048 + k * 1024); } while (0)
#define PG8_LDB(dst, b, h) do { _Pragma("unroll") for (int n = 0; n < 2; ++n) _Pragma("unroll") for (int k = 0; k < 2; ++k) dst[n][k] = *(const PG8_LAS bf16x8*)(lds + PG8_SB(b, h) + boff + n * 2048 + k * 1024); } while (0)
#define PG8_MMA(ai, bj, At, Bt) do { __builtin_amdgcn_s_setprio(1); _Pragma("unroll") for (int m = 0; m < 4; ++m) _Pragma("unroll") for (int n = 0; n < 2; ++n) _Pragma("unroll") for (int k = 0; k < 2; ++k) \
        acc[ai][bj][m][n] = __builtin_amdgcn_mfma_f32_16x16x32_bf16(Bt[n][k], At[m][k], acc[ai][bj][m][n], 0, 0, 0); __builtin_amdgcn_s_setprio(0); } while (0)
#define PG8_WAIT_V(n) asm volatile("s_waitcnt vmcnt(" #n ")" ::: "memory")
#define PG8_WAIT_L(n) asm volatile("s_waitcnt lgkmcnt(" #n ")" ::: "memory")
#define PG8_BAR __builtin_amdgcn_s_barrier()
#define PG8_SCHED __builtin_amdgcn_sched_barrier(0)
    Unit cur, nxt; int ui = 0;
    if (!S.next(0, cur)) return;
    f32x4 acc[2][2][4][2];
#pragma unroll
    for (int a = 0; a < 2; ++a)
#pragma unroll
        for (int b = 0; b < 2; ++b)
#pragma unroll
            for (int m = 0; m < 4; ++m)
#pragma unroll
                for (int n = 0; n < 2; ++n) acc[a][b][m][n] = (f32x4){0.f, 0.f, 0.f, 0.f};
    bf16x8 At[4][2], B0[2][2], B1[2][2];
    const char* cA = (const char*)g.A + (size_t)cur.pm * tstep + (size_t)cur.kt0 * kstep; const char* cB = (const char*)g.Bt + (size_t)cur.pn * tstep + (size_t)cur.kt0 * kstep;
    S.a_ready(cur);
    if constexpr (SP2) {
        PG8_STAGE(PG8_SB(0, 0), cB, voffB); PG8_STAGE(PG8_SB(0, 1), cB + hstep, voffB); PG8_STAGE(PG8_SA(0, 0), cA, voffA); PG8_STAGE(PG8_SA(0, 1), cA + hstep, voffA);
        if (wr == 1) PG8_BAR;
        PG8_WAIT_V(2); PG8_BAR;
        PG8_STAGE(PG8_SB(1, 0), cB + kstep, voffB); PG8_STAGE(PG8_SA(1, 0), cA + kstep, voffA); PG8_STAGE(PG8_SB(1, 1), cB + hstep + kstep, voffB);
        PG8_WAIT_V(6); PG8_BAR;
    }
    for (;;) {
        const bool has_next = S.next(ui + 1, nxt);
        const char* nA = has_next ? (const char*)g.A + (size_t)nxt.pm * tstep + (size_t)nxt.kt0 * kstep : cA; const char* nB = has_next ? (const char*)g.Bt + (size_t)nxt.pn * tstep + (size_t)nxt.kt0 * kstep : cB;
        const int nt = cur.nkt; const bool full = !(cur.flags & 1);
        for (int t = 0; t < nt; t += 2) {
            const bool last = (t == nt - 2);
            const char* a1 = cA + (size_t)(t + 1) * kstep;
            const char* a2 = last ? nA : cA + (size_t)(t + 2) * kstep; const char* b2 = last ? nB : cB + (size_t)(t + 2) * kstep;
            const char* a3 = a2 + kstep; const char* b3 = b2 + kstep;
            if (last && has_next) S.a_ready(nxt);
            if constexpr (SP2) {
            PG8_LDB(B0, 0, 0); PG8_LDB(B1, 0, 1); PG8_SCHED; PG8_LDA(At, 0, 0); PG8_STAGE(PG8_SA(1, 1), a1 + hstep, voffA);
            PG8_WAIT_V(8); PG8_WAIT_L(0); PG8_BAR; PG8_MMA(0, 0, At, B0); PG8_MMA(0, 1, At, B1); PG8_BAR; PG8_SCHED;
            if (full) { PG8_LDA(At, 0, 1); } PG8_STAGE(PG8_SB(0, 0), b2, voffB); PG8_STAGE(PG8_SB(0, 1), b2 + hstep, voffB); PG8_STAGE(PG8_SA(0, 0), a2, voffA);
            PG8_WAIT_V(8); PG8_WAIT_L(0); PG8_BAR; if (full) { PG8_MMA(1, 0, At, B0); PG8_MMA(1, 1, At, B1); } PG8_BAR; PG8_SCHED;
            PG8_LDB(B0, 1, 0); PG8_LDB(B1, 1, 1); PG8_SCHED; PG8_LDA(At, 1, 0); PG8_STAGE(PG8_SA(0, 1), a2 + hstep, voffA);
            PG8_WAIT_V(8); PG8_WAIT_L(0); PG8_BAR; PG8_MMA(0, 0, At, B0); PG8_MMA(0, 1, At, B1); PG8_BAR; PG8_SCHED;
            if (full) { PG8_LDA(At, 1, 1); } PG8_STAGE(PG8_SB(1, 0), b3, voffB); PG8_STAGE(PG8_SB(1, 1), b3 + hstep, voffB); PG8_STAGE(PG8_SA(1, 0), a3, voffA);
            PG8_WAIT_V(8); PG8_WAIT_L(0); PG8_BAR; if (full) { PG8_MMA(1, 0, At, B0); PG8_MMA(1, 1, At, B1); } PG8_BAR; PG8_SCHED;
            }
        }
        if constexpr (ALIGN_EPI) { if (wr == 0) PG8_BAR; }
        E(acc, cur, wr, wc, fr, fq); S.done(cur);
        if (!has_next) break;
#pragma unroll
        for (int a = 0; a < 2; ++a)
#pragma unroll
            for (int b = 0; b < 2; ++b)
#pragma unroll
                for (int m = 0; m < 4; ++m)
#pragma unroll
                    for (int n = 0; n < 2; ++n) acc[a][b][m][n] = (f32x4){0.f, 0.f, 0.f, 0.f};
        cur = nxt; cA = nA; cB = nB; ++ui;
        if constexpr (ALIGN_EPI) { if (wr == 1) PG8_BAR; }
    }
    PG8_WAIT_V(0);
    if constexpr (!ALIGN_EPI) { if (wr == 0) PG8_BAR; }
    PG8_BAR;
#undef PG8_SA
#undef PG8_SB
#undef PG8_STAGE
#undef PG8_LDA
#undef PG8_LDB
#undef PG8_MMA
#undef PG8_WAIT_V
#undef PG8_WAIT_L
#undef PG8_BAR
#undef PG8_SCHED
}
}

#ifndef PG8_SP2
#define PG8_SP2 true
#endif
#ifndef PG8_ALIGN
#define PG8_ALIGN true
#endif

constexpr int NWAVES = 8;
constexpr int D = 4096, NPROMPT = 8192, SEQ = 2048, NB = 4, NSAMP = 128, MREAL = NPROMPT + NSAMP, M = 8448  ;
constexpr int DFF = 11008, INW = 14336, SW = 2048, GW = 2048, NGRP = 128, NST = 64, GCH = 16, NHEAD = 16, HD = 128, CHUNK = 128;
constexpr int TCH = 64, NCH = SEQ / TCH;
constexpr float EPS = 1e-6f;
constexpr int N_PHASES = 14;
#ifndef MK_UP2_SPLIT
#define MK_UP2_SPLIT 12
#endif
constexpr int UP2_SPLIT = MK_UP2_SPLIT;
#ifndef MK_NG1
#define MK_NG1 224
#endif
#ifndef MK_NG4
#define MK_NG4 224
#endif
constexpr int NG4 = MK_NG4;
#ifndef MK_NG11
#define MK_NG11 240
#endif
constexpr int NG11 = MK_NG11;
constexpr int NG1 = MK_NG1;
constexpr size_t O_YP = 0, O_YS = (size_t)NPROMPT * D, O_PRE = O_YS + (size_t)NSAMP * D, O_PIM = O_PRE + (size_t)NB * NGRP * NST, O_SRE = O_PIM + (size_t)NB * NGRP * NST,
                 O_SIM = O_SRE + (size_t)NSAMP * NGRP * NST, O_V = O_SIM + (size_t)NSAMP * NGRP * NST, O_END = O_V + (size_t)NSAMP * GW;

constexpr size_t MiB = 1u << 20;
constexpr size_t WS_CTL = 0, CTL_ZERO_BYTES = 32768;
constexpr size_t WS_ABAR = 1 * MiB;
constexpr size_t WS_AT = WS_ABAR + 65536;
constexpr size_t WS_BB = WS_AT + 65536;
constexpr size_t WS_RS = 3 * MiB;
constexpr size_t WS_E = 4 * MiB;
constexpr size_t WS_WGU1 = 12 * MiB, WS_WD1 = 184 * MiB, WS_WIN = 270 * MiB, WS_WGLU = 382 * MiB, WS_WGOUT = 414 * MiB, WS_WOUT = 430 * MiB, WS_WGU2 = 462 * MiB, WS_WD2 = 634 * MiB;
constexpr size_t WS_XRES = 720 * MiB;
constexpr size_t WS_XSAMP = WS_XRES + (size_t)M * D * 2;
constexpr size_t WS_H = 852 * MiB;
constexpr size_t WS_ACT = 918 * MiB;
constexpr size_t WS_U = 918 * MiB, WS_GU = 951 * MiB, WS_GV = 984 * MiB, WS_GS = 1017 * MiB, WS_GG = 1083 * MiB, WS_Y = 1149 * MiB, WS_S2 = 1182 * MiB, WS_T = 1215 * MiB;
constexpr size_t WS_PART = 1281 * MiB;
constexpr int NSPLIT = 16;
constexpr size_t WS_PARTW = 1313 * MiB;
constexpr int NSPLITW = 4;
constexpr size_t WS_PARTG = 1343 * MiB;
constexpr int NSPLITG = 4;
constexpr size_t WS_END = 1352 * MiB;
static_assert(WS_E + (size_t)NB * NCH * NGRP * NST * 8 <= WS_WGU1 && WS_WGU1 + (size_t)2 * DFF * D * 2 <= WS_WD1 && WS_WD1 + (size_t)D * DFF * 2 <= WS_WIN && WS_WIN + (size_t)INW * D * 2 <= WS_WGLU, "ws map 1");
static_assert(WS_WGLU + (size_t)2 * D * SW * 2 <= WS_WGOUT && WS_WGOUT + (size_t)D * GW * 2 <= WS_WOUT && WS_WOUT + (size_t)D * D * 2 <= WS_WGU2 && WS_WGU2 + (size_t)2 * DFF * D * 2 <= WS_WD2 && WS_WD2 + (size_t)D * DFF * 2 <= WS_XRES, "ws map 2");
static_assert(WS_XRES + (size_t)M * D * 4 <= WS_H && WS_H + (size_t)M * D * 2 <= WS_ACT && WS_ACT + (size_t)M * DFF * 2 <= WS_PART, "ws map 3");
static_assert(WS_U + (size_t)M * SW * 2 <= WS_GU && WS_GU + (size_t)M * GW * 2 <= WS_GV && WS_GV + (size_t)M * GW * 2 <= WS_GS && WS_GS + (size_t)M * D * 2 <= WS_GG && WS_GG + (size_t)M * D * 2 <= WS_Y &&
              WS_Y + (size_t)M * SW * 2 <= WS_S2 && WS_S2 + (size_t)M * GW * 2 <= WS_T && WS_T + (size_t)M * D * 2 <= WS_PART && WS_PART + (size_t)NSPLIT * NSAMP * D * 4 <= WS_PARTW && WS_PARTW + (size_t)NSPLITW * NSAMP * INW * 4 <= WS_PARTG && WS_PARTG + (size_t)NSPLITG * NSAMP * D * 4 <= WS_END, "ws map 4");
#ifndef MK_GATE_G0
#define MK_GATE_G0 14
#endif
#ifndef MK_GATE_SG
#define MK_GATE_SG 12
#endif
constexpr int GATE_G0 = MK_GATE_G0, GATE_SG = MK_GATE_SG;
constexpr int NPN1 = 2 * 11008 / 256;
constexpr int CW_GATE = 64;
constexpr int CW_BAR = 4096;

constexpr int RING_OFF = 0, RING_BYTES = 131072;
constexpr int LDSCTL_OFF = RING_BYTES, MISC_OFF = LDSCTL_OFF + 320;
constexpr int LDS_BYTES = 147456;
static_assert(MISC_OFF + 128 <= LDS_BYTES, "LDS map");
static_assert((CW_BAR + 3456) * 4 <= (int)CTL_ZERO_BYTES, "barrier words inside the per-call memset");

#define GAS __attribute__((address_space(1)))
#define LAS __attribute__((address_space(3)))
typedef unsigned short bf16;
typedef unsigned v4u __attribute__((ext_vector_type(4)));
typedef unsigned v2u __attribute__((ext_vector_type(2)));
typedef float f32x4 __attribute__((ext_vector_type(4)));
typedef float f32x2 __attribute__((ext_vector_type(2)));
typedef short bf16x8 __attribute__((ext_vector_type(8)));
typedef GAS unsigned gu32;
#define RLX_AGENT __ATOMIC_RELAXED, __HIP_MEMORY_SCOPE_AGENT
#define LDS_WAIT() asm volatile("s_waitcnt lgkmcnt(0)" ::: "memory")
using pg8::cvt_pk_bf16; using pg8::bflo; using pg8::bfhi; using pg8::fgelu; using pg8::fsigmoid;

#define XB_TMO      128
#define XB_XCNT(j)  (256  + 64 * (j))
#define XB_XSUB(j)  (1280 + 64 * (j))
#define XB_XGEN(j)  (2304 + 64 * (j))
#define XB_TOP      3328
#define XB_TOPGEN   3392
#define XCD_BAR_WORDS 3456
#define XB_SPIN_CAP (1u << 18)
__device__ __forceinline__ unsigned xb_ld(unsigned* p)              { return __hip_atomic_load(p, __ATOMIC_RELAXED, __HIP_MEMORY_SCOPE_AGENT); }
__device__ __forceinline__ unsigned xb_add(unsigned* p, unsigned v) { return __hip_atomic_fetch_add(p, v, __ATOMIC_RELAXED, __HIP_MEMORY_SCOPE_AGENT); }
__device__ __forceinline__ unsigned xb_xcc_id() { return (unsigned)__builtin_amdgcn_s_getreg((3 << 11) | 20) & 0xFu; }
#define XB_SPIN(cond, bar) do { unsigned _sp = 0; while (cond) { __builtin_amdgcn_s_sleep(1); \
    if ((++_sp & 255u) == 0u) { if (xb_ld(&(bar)[XB_TMO])) break; if (_sp > XB_SPIN_CAP) { atomicAdd(&(bar)[XB_TMO], 1u); break; } } } } while (0)
struct XcdBarrier { unsigned* bar; unsigned x; volatile LAS unsigned* st; };
__device__ __forceinline__ XcdBarrier xcd_barrier_post(unsigned* bar, volatile LAS unsigned* st) {
    XcdBarrier b; b.bar = bar; b.x = xb_xcc_id(); b.st = st;
    if (threadIdx.x == 0) (void)xb_add(&bar[XB_XCNT(b.x)], 1u);
    return b;
}
__device__ __forceinline__ void xcd_barrier_complete(unsigned* bar, unsigned x, unsigned& nloc, unsigned& nx) {
    const unsigned G = gridDim.x * gridDim.y * gridDim.z;
    unsigned sum, cnt, mine, sp = 0u;
    for (;;) {
        sum = 0u; cnt = 0u; mine = 0u;
#pragma unroll
        for (unsigned j = 0; j < 16; ++j) { const unsigned c = xb_ld(&bar[XB_XCNT(j)]); sum += c; cnt += (c > 0u) ? 1u : 0u; mine = (j == x) ? c : mine; }
        if (sum == G) break;
        __builtin_amdgcn_s_sleep(1);
        if ((++sp & 255u) == 0u) { if (xb_ld(&bar[XB_TMO])) break; if (sp > XB_SPIN_CAP) { atomicAdd(&bar[XB_TMO], 1u); break; } }
    }
    nloc = mine > 0u ? mine : 1u; nx = cnt > 0u ? cnt : 1u;
}
__device__ __forceinline__ void xcd_barrier(const XcdBarrier& b) {
    asm volatile("s_waitcnt vmcnt(0)" ::: "memory");
    __syncthreads();
    if (threadIdx.x == 0) {
        unsigned* bar = b.bar;
        __builtin_amdgcn_s_waitcnt(0);
        unsigned nloc = b.st[0], nx = b.st[1];
        if (nloc == 0u) { xcd_barrier_complete(bar, b.x, nloc, nx); b.st[0] = nloc; b.st[1] = nx; }
        const unsigned old = xb_add(&bar[XB_XSUB(b.x)], 1u);
        const unsigned gen = old / nloc;
        if (old + 1u == (gen + 1u) * nloc) {
            __builtin_amdgcn_fence(__ATOMIC_RELEASE, "agent");
            asm volatile("s_waitcnt vmcnt(0)" ::: "memory");
            const unsigned og = xb_add(&bar[XB_TOP], 1u);
            const unsigned tg = og / nx;
            if (og + 1u == (tg + 1u) * nx) xb_add(&bar[XB_TOPGEN], 1u);
            else XB_SPIN(xb_ld(&bar[XB_TOPGEN]) == tg, bar);
            __builtin_amdgcn_fence(__ATOMIC_ACQUIRE, "agent");
            xb_add(&bar[XB_XGEN(b.x)], 1u);
            asm volatile("s_waitcnt vmcnt(0)" ::: "memory");
        } else {
            XB_SPIN(xb_ld(&bar[XB_XGEN(b.x)]) == gen, bar);
            __builtin_amdgcn_fence(__ATOMIC_ACQUIRE, "agent");
            asm volatile("s_waitcnt vmcnt(0)" ::: "memory");
        }
    }
    __syncthreads();
}

struct Args { const float* in[29]; float* out; unsigned char* ws; int ph_lo, ph_hi; };
struct Frame {
    LAS unsigned char* lds;
    int tid, lane, wave, gw, ngw;
    unsigned char* ws; float* out;
};
__device__ __forceinline__ float wave_sum(float v) {
#pragma unroll
    for (int o = 1; o < 64; o <<= 1) v += __shfl_xor(v, o);
    return v;
}

__device__ __forceinline__ int map_row(int n, int mode) {
    if (mode == 0) return n;
    if (mode == 3) { const int h = n >= D ? 1 : 0, n2 = n - h * D; return 256 * (n2 >> 7) + 128 * h + (n2 & 127); }
    return 256 * (n >> 7) + 128 * (mode - 1) + (n & 127);
}
__device__ __forceinline__ void p0_item_load(const float* __restrict__ W, int N, int nblk, int nb0, int item, int lane, f32x4 (&v)[8]) {
    const int kb = item / nblk, nb = nb0 + item % nblk;
    const float* src = W + (size_t)(64 * kb + (lane >> 3)) * N + 32 * nb + 4 * (lane & 7);
#pragma unroll
    for (int i = 0; i < 8; ++i) v[i] = __builtin_nontemporal_load((const f32x4*)(src + (size_t)(8 * i) * N));
}
__device__ __forceinline__ void p0_item_store(const f32x4 (&v)[8], int K, int nblk, int nb0, bf16* __restrict__ WT, int mode, LAS float* scr, int item, int lane) {
    const int kb = item / nblk, nb = nb0 + item % nblk, k0 = 64 * kb, n0 = 32 * nb;
#pragma unroll
    for (int i = 0; i < 8; ++i) { LAS float* d = scr + (8 * i + (lane >> 3)) * 33 + 4 * (lane & 7); d[0] = v[i].x; d[1] = v[i].y; d[2] = v[i].z; d[3] = v[i].w; }
    LDS_WAIT(); asm volatile("" ::: "memory");
    const int c = lane & 7, r0 = map_row(n0, mode);
    const float wsc = mode == 1 ? 1.44269504089f : (mode == 2 ? 0.69314718056f : 1.0f);
#pragma unroll
    for (int j = 0; j < 4; ++j) { const int n = (lane >> 3) + 8 * j; const LAS float* s = scr + (8 * c) * 33 + n;
        v4u o; o.x = cvt_pk_bf16(s[0 * 33] * wsc, s[1 * 33] * wsc); o.y = cvt_pk_bf16(s[2 * 33] * wsc, s[3 * 33] * wsc); o.z = cvt_pk_bf16(s[4 * 33] * wsc, s[5 * 33] * wsc); o.w = cvt_pk_bf16(s[6 * 33] * wsc, s[7 * 33] * wsc);
        *(v4u*)(WT + (size_t)(r0 + n) * K + k0 + 8 * c) = o; }
    LDS_WAIT(); asm volatile("" ::: "memory");
}
__device__ __forceinline__ void p0_transpose(Frame& F, const float* W, int K, int N, bf16* WT, int mode, int w0, int nw, int f0 = 0, int f1 = 16, int nb0 = 0, int nbn = 0) {
    LAS float* scr = (LAS float*)(F.lds + RING_OFF + F.wave * 16384);
    const int nblk = nbn ? nbn : N / 32, nall = (K / 64) * nblk, nitems = (int)((long)nall * f1 / 16);
    int it = (int)((long)nall * f0 / 16) + w0; if (it >= nitems) return;
    f32x4 va[8], vb[8], vc[8];
    __builtin_amdgcn_s_waitcnt(0x0F70);
    const int last = nitems - 1, ntri = ((nitems - it + nw - 1) / nw + 2) / 3;
    int i1 = min(it + nw, last);
    p0_item_load(W, N, nblk, nb0, it, F.lane, va);
    p0_item_load(W, N, nblk, nb0, i1, F.lane, vb); __builtin_amdgcn_sched_barrier(0);
    for (int p = 0; p < ntri; ++p) {
        const int i2 = min(i1 + nw, last), i3 = min(i2 + nw, last), i4 = min(i3 + nw, last);
        p0_item_load(W, N, nblk, nb0, i2, F.lane, vc); __builtin_amdgcn_sched_barrier(0);
        p0_item_store(va, K, nblk, nb0, WT, mode, scr, it, F.lane); __builtin_amdgcn_sched_barrier(0);
        p0_item_load(W, N, nblk, nb0, i3, F.lane, va); __builtin_amdgcn_sched_barrier(0);
        p0_item_store(vb, K, nblk, nb0, WT, mode, scr, i1, F.lane); __builtin_amdgcn_sched_barrier(0);
        p0_item_load(W, N, nblk, nb0, i4, F.lane, vb); __builtin_amdgcn_sched_barrier(0);
        p0_item_store(vc, K, nblk, nb0, WT, mode, scr, i2, F.lane); __builtin_amdgcn_sched_barrier(0);
        it = i3; i1 = i4;
    }
}
__device__ __forceinline__ void load_gain(const float* gain, int lane, f32x4 (&gn)[16]) {
#pragma unroll
    for (int j = 0; j < 16; ++j) gn[j] = ((const f32x4*)gain + lane)[64 * j];
}
template <bool COPY> __device__ __forceinline__ void rms_row_bf16(const float* xrow, const f32x4 (&gn)[16], bf16* orow, float* xcopy, int lane) {
    const f32x4* xr = (const f32x4*)xrow + lane;
    f32x4 v[16]; float s = 0.f;
#pragma unroll
    for (int j = 0; j < 16; ++j) { v[j] = xr[64 * j]; s += (v[j].x * v[j].x + v[j].y * v[j].y) + (v[j].z * v[j].z + v[j].w * v[j].w); }
    if (COPY) {
#pragma unroll
        for (int j = 0; j < 16; ++j) ((f32x4*)xcopy + lane)[64 * j] = v[j]; }
    const float r = 1.0f / sqrtf(wave_sum(s) * (1.0f / D) + EPS);
    v2u* o8 = (v2u*)orow + lane;
#pragma unroll
    for (int j = 0; j < 16; ++j) { const f32x4 g = gn[j]; v2u w; w.x = cvt_pk_bf16(v[j].x * r * g.x, v[j].y * r * g.y); w.y = cvt_pk_bf16(v[j].z * r * g.z, v[j].w * r * g.w); o8[64 * j] = w; }
}
__device__ __forceinline__ void rms_row_f32(const float* xrow, const f32x4 (&gn)[16], float* orow, int lane) {
    const f32x4* xr = (const f32x4*)xrow + lane;
    f32x4 v[16]; float s = 0.f;
#pragma unroll
    for (int j = 0; j < 16; ++j) { v[j] = xr[64 * j]; s += (v[j].x * v[j].x + v[j].y * v[j].y) + (v[j].z * v[j].z + v[j].w * v[j].w); }
    const float r = 1.0f / sqrtf(wave_sum(s) * (1.0f / D) + EPS);
#pragma unroll
    for (int j = 0; j < 16; ++j) ((f32x4*)orow + lane)[64 * j] = v[j] * r * gn[j];
}
__device__ __forceinline__ double dexp(double x) {
    const double kf = __builtin_rint(x * 1.4426950408889634); const double r = x - kf * 0.6931471805599453094;
    double p = 1.0 / 6227020800.0;
    p = p * r + 1.0 / 479001600.0; p = p * r + 1.0 / 39916800.0; p = p * r + 1.0 / 3628800.0; p = p * r + 1.0 / 362880.0; p = p * r + 1.0 / 40320.0; p = p * r + 1.0 / 5040.0;
    p = p * r + 1.0 / 720.0; p = p * r + 1.0 / 120.0; p = p * r + 1.0 / 24.0; p = p * r + 1.0 / 6.0; p = p * r + 0.5; p = p * r + 1.0; p = p * r + 1.0;
    const long long k = (long long)kf; const double sc = __longlong_as_double((k + 1023ll) << 52);
    return p * sc;
}
__device__ __forceinline__ void dsincos(double th, double& s, double& c) {
    const double qf = __builtin_rint(th * 0.63661977236758134308); const double r = (th - qf * 1.57079632679489655800) - qf * 6.123233995736766036e-17;
    const double r2 = r * r;
    double ps = -1.0 / 1307674368000.0; ps = ps * r2 + 1.0 / 6227020800.0; ps = ps * r2 - 1.0 / 39916800.0; ps = ps * r2 + 1.0 / 362880.0; ps = ps * r2 - 1.0 / 5040.0; ps = ps * r2 + 1.0 / 120.0; ps = ps * r2 - 1.0 / 6.0; ps = ps * r2 + 1.0; ps = ps * r;
    double pc = 1.0 / 20922789888000.0; pc = pc * r2 - 1.0 / 87178291200.0; pc = pc * r2 + 1.0 / 479001600.0; pc = pc * r2 - 1.0 / 3628800.0; pc = pc * r2 + 1.0 / 40320.0; pc = pc * r2 - 1.0 / 720.0; pc = pc * r2 + 1.0 / 24.0; pc = pc * r2 - 0.5; pc = pc * r2 + 1.0;
    const int q = (int)((long long)qf & 3ll);
    s = (q == 0) ? ps : (q == 1) ? pc : (q == 2) ? -ps : -pc;
    c = (q == 0) ? pc : (q == 1) ? -ps : (q == 2) ? -pc : ps;
}

__device__ __forceinline__ void ssm_discretise(Frame& F, const Args& A, int gt) {
    if (gt < NGRP * NST) {
        const int g = gt >> 6;
        const f32x4* bre4 = (const f32x4*)(A.in[13] + (size_t)gt * GCH); const f32x4* bim4 = (const f32x4*)(A.in[14] + (size_t)gt * GCH);
        f32x4 br4[4], bi4[4];
#pragma unroll
        for (int q = 0; q < 4; ++q) { br4[q] = bre4[q]; bi4[q] = bim4[q]; }
        const double lre = (double)A.in[10][gt], lim = (double)A.in[11][gt], dt = dexp((double)A.in[12][g]);
        const double mag = dexp(dt * lre); double sn, cs; dsincos(dt * lim, sn, cs);
        const double are = mag * cs, aim = mag * sn;
        const double magT = dexp((double)TCH * dt * lre); double snT, csT; dsincos((double)TCH * dt * lim, snT, csT);
        ((f32x2*)(F.ws + WS_ABAR))[gt] = (f32x2){(float)are, (float)aim};
        ((f32x2*)(F.ws + WS_AT))[gt] = (f32x2){(float)(magT * csT), (float)(magT * snT)};
        const double nr = are - 1.0, ni = aim, den = lre * lre + lim * lim;
        const double cre = (nr * lre + ni * lim) / den, cim = (ni * lre - nr * lim) / den;
        f32x4* bb4 = (f32x4*)((float*)(F.ws + WS_BB) + (size_t)gt * 32);
#pragma unroll
        for (int q = 0; q < 4; ++q) { f32x4 o_re, o_im;
#pragma unroll
            for (int j = 0; j < 4; ++j) { const double br = (double)br4[q][j], bi = (double)bi4[q][j]; o_re[j] = (float)(cre * br - cim * bi); o_im[j] = (float)(cre * bi + cim * br); }
            bb4[q] = o_re; bb4[4 + q] = o_im; }
    }
}
__device__ __forceinline__ void p0_prologue(Frame& F, const Args& A) {
    bf16* const wsb = (bf16*)F.ws;
    { f32x4 gn[16]; load_gain(A.in[4], F.lane, gn);
    for (int m = F.gw; m < M; m += F.ngw) {
        bf16* hr = (bf16*)(F.ws + WS_H) + (size_t)m * D;
        if (m < MREAL) { const float* src = m < NPROMPT ? A.in[0] + (size_t)m * D : A.in[1] + (size_t)(m - NPROMPT) * D; rms_row_bf16<false>(src, gn, hr, nullptr, F.lane); }
        else {
#pragma unroll
            for (int j = 0; j < 16; ++j) ((v2u*)hr + F.lane)[64 * j] = (v2u){0u, 0u};
            v4u z = (v4u){0u, 0u, 0u, 0u};
#pragma unroll
            for (int j = 0; j < 4; ++j) { ((v4u*)((bf16*)(F.ws + WS_Y) + (size_t)m * SW) + F.lane)[64 * j] = z; ((v4u*)((bf16*)(F.ws + WS_S2) + (size_t)m * GW) + F.lane)[64 * j] = z; }
        }
    } }
    p0_transpose(F, A.in[5], D, DFF, (bf16*)(F.ws + WS_WGU1), 1, F.gw, F.ngw, 0, 16, 0, 4 * GATE_G0);
    p0_transpose(F, A.in[6], D, DFF, (bf16*)(F.ws + WS_WGU1), 2, F.gw, F.ngw, 0, 16, 0, 4 * GATE_G0);
    p0_transpose(F, A.in[26], D, DFF, (bf16*)(F.ws + WS_WGU2), 2, F.gw, F.ngw, UP2_SPLIT, 16);
    (void)wsb;
}
__device__ __forceinline__ void convert_beside_ffn1(Frame& F, const Args& A, int w0, int nw) {
#pragma unroll 1
    for (int t0 = GATE_G0; t0 < NPN1; t0 += GATE_SG) { const int tn = min(GATE_SG, NPN1 - t0);
        p0_transpose(F, A.in[5], D, DFF, (bf16*)(F.ws + WS_WGU1), 1, w0, nw, 0, 16, 4 * t0, 4 * tn);
        p0_transpose(F, A.in[6], D, DFF, (bf16*)(F.ws + WS_WGU1), 2, w0, nw, 0, 16, 4 * t0, 4 * tn);
        __syncthreads();
        if (F.tid == 0) { __threadfence(); __hip_atomic_fetch_add((unsigned*)(F.ws + WS_CTL) + CW_GATE, 1u, __ATOMIC_RELEASE, __HIP_MEMORY_SCOPE_AGENT); }
    }
    p0_transpose(F, A.in[7], DFF, D, (bf16*)(F.ws + WS_WD1), 0, w0, nw);
    p0_transpose(F, A.in[9], D, INW, (bf16*)(F.ws + WS_WIN), 0, w0, nw);
    p0_transpose(F, A.in[22], GW, D, (bf16*)(F.ws + WS_WGOUT), 0, w0, nw);
}
__device__ __forceinline__ void convert_beside_ffn2(Frame& F, const Args& A, int w0, int nw) {
    p0_transpose(F, A.in[27], DFF, D, (bf16*)(F.ws + WS_WD2), 0, w0, nw);
}
__device__ __forceinline__ void convert_beside_win(Frame& F, const Args& A, int w0, int nw) {
    p0_transpose(F, A.in[25], D, DFF, (bf16*)(F.ws + WS_WGU2), 1, w0, nw);
    p0_transpose(F, A.in[26], D, DFF, (bf16*)(F.ws + WS_WGU2), 2, w0, nw, 0, UP2_SPLIT);
    p0_transpose(F, A.in[18], SW, 2 * D, (bf16*)(F.ws + WS_WGLU), 3, w0, nw);
    p0_transpose(F, A.in[23], D, D, (bf16*)(F.ws + WS_WOUT), 0, w0, nw);
}
template <bool FINAL> __device__ __forceinline__ void norm_sample_row(Frame& F, const float* gain, float scale, const float* samp_base, float* outf) {
    if ((int)blockIdx.x < NSAMP) {
        const int i = blockIdx.x, m = NPROMPT + i, col = 512 * F.wave + 4 * F.lane;
        float* xr = (float*)(F.ws + WS_XSAMP) + (size_t)i * D + col;
        const float* src = samp_base ? samp_base + (size_t)i * D + col : xr;
        f32x4 v0 = *(const f32x4*)src, v1 = *(const f32x4*)(src + 256);
        const float* pr = (const float*)(F.ws + WS_PART) + (size_t)i * D + col;
        f32x4 p0[NSPLIT], p1[NSPLIT];
#pragma unroll
        for (int ks = 0; ks < NSPLIT; ++ks) { p0[ks] = *(const f32x4*)(pr + (size_t)ks * NSAMP * D); p1[ks] = *(const f32x4*)(pr + (size_t)ks * NSAMP * D + 256); }
#pragma unroll
        for (int ks = 0; ks < NSPLIT; ++ks) { v0 = v0 + p0[ks] * scale; v1 = v1 + p1[ks] * scale; }
        if (!FINAL) { *(f32x4*)xr = v0; *(f32x4*)(xr + 256) = v1; }
        float sq = (v0.x * v0.x + v0.y * v0.y) + (v0.z * v0.z + v0.w * v0.w) + (v1.x * v1.x + v1.y * v1.y) + (v1.z * v1.z + v1.w * v1.w);
        sq = wave_sum(sq);
        LAS float* red = (LAS float*)(F.lds + RING_OFF);
        if (F.lane == 0) red[F.wave] = sq;
        __syncthreads();
        float tot = 0.f;
#pragma unroll
        for (int w = 0; w < NWAVES; ++w) tot += red[w];
        const float r = 1.0f / sqrtf(tot * (1.0f / D) + EPS);
        const f32x4 g0 = *(const f32x4*)(gain + col), g1 = *(const f32x4*)(gain + col + 256);
        if (FINAL) { *(f32x4*)(outf + (size_t)m * D + col) = v0 * r * g0; *(f32x4*)(outf + (size_t)m * D + col + 256) = v1 * r * g1; }
        else { bf16* hr = (bf16*)(F.ws + WS_H) + (size_t)m * D + col;
            v2u w0, w1; w0.x = cvt_pk_bf16(v0.x * r * g0.x, v0.y * r * g0.y); w0.y = cvt_pk_bf16(v0.z * r * g0.z, v0.w * r * g0.w); w1.x = cvt_pk_bf16(v1.x * r * g1.x, v1.y * r * g1.y); w1.y = cvt_pk_bf16(v1.z * r * g1.z, v1.w * r * g1.w);
            *(v2u*)hr = w0; *(v2u*)(hr + 256) = w1; }
        __syncthreads();
    }
}
__device__ __forceinline__ void load_gain8(const float* gain, int lane, f32x4 (&gn)[16]) {
#pragma unroll
    for (int j = 0; j < 8; ++j) { gn[2 * j] = *(const f32x4*)(gain + 8 * (64 * j + lane)); gn[2 * j + 1] = *(const f32x4*)(gain + 8 * (64 * j + lane) + 4); }
}
__device__ __forceinline__ void load_xrow(Frame& F, int m, f32x4 (&v)[16]) {
    const v4u* xr = (const v4u*)((const bf16*)(F.ws + WS_XRES) + (size_t)m * D) + F.lane;
    v4u w[8];
#pragma unroll
    for (int j = 0; j < 8; ++j) w[j] = xr[64 * j];
#pragma unroll
    for (int j = 0; j < 8; ++j) pg8::unpack8(w[j], v[2 * j], v[2 * j + 1]);
}
__device__ __forceinline__ float row_rnorm(const f32x4 (&v)[16]) {
    float s = 0.f;
#pragma unroll
    for (int j = 0; j < 16; ++j) s += (v[j].x * v[j].x + v[j].y * v[j].y) + (v[j].z * v[j].z + v[j].w * v[j].w);
    return 1.0f / sqrtf(wave_sum(s) * (1.0f / D) + EPS);
}
__device__ __forceinline__ void norm_phase(Frame& F, const float* gain, int nsplit, float scale, const float* samp_base) {
    (void)nsplit;
    norm_sample_row<false>(F, gain, scale, samp_base, nullptr);
    f32x4 gn[16]; load_gain8(gain, F.lane, gn);
    for (int m = F.gw; m < NPROMPT; m += F.ngw) {
        f32x4 v[16]; load_xrow(F, m, v);
        const float r = row_rnorm(v);
        v4u* o8 = (v4u*)((bf16*)(F.ws + WS_H) + (size_t)m * D) + F.lane;
#pragma unroll
        for (int j = 0; j < 8; ++j) o8[64 * j] = pg8::pack8(v[2 * j] * r * gn[2 * j], v[2 * j + 1] * r * gn[2 * j + 1]);
    }
}
__device__ __forceinline__ void final_norm_phase(Frame& F, const Args& A, int nsplit, float scale) {
    (void)nsplit;
    norm_sample_row<true>(F, A.in[28], scale, nullptr, F.out);
    f32x4 gn[16]; load_gain8(A.in[28], F.lane, gn);
    for (int m = F.gw; m < NPROMPT; m += F.ngw) {
        f32x4 v[16]; load_xrow(F, m, v);
        const float r = row_rnorm(v);
#pragma unroll
        for (int j = 0; j < 8; ++j) { f32x4* o = (f32x4*)(F.out + (size_t)m * D + 8 * (64 * j + F.lane)); o[0] = v[2 * j] * r * gn[2 * j]; o[1] = v[2 * j + 1] * r * gn[2 * j + 1]; }
    }
}

#define MFMA_PIN(a, b) do { __builtin_amdgcn_sched_barrier(0); asm volatile("" :: "v"(a), "v"(b)); } while (0)
#define MFMA_SETTLE() do { __builtin_amdgcn_sched_barrier(0); asm volatile("s_nop 15"); __builtin_amdgcn_sched_barrier(0); } while (0)
constexpr int BUP = 132, SSM_BU_BYTES = 16 * BUP * 4, SSM_LDS_W = SSM_BU_BYTES + 4352;
__device__ __forceinline__ void ssm_bfrag_raw(Frame& F, int g, int lane, f32x4 (&x)[8][2]) {
    const int hs = ((lane >> 4) & 1) * 8;
#pragma unroll
    for (int cb = 0; cb < 8; ++cb) { const int col = 16 * cb + (lane & 15), p = col & 63, im = col >> 6;
        const float* src = (const float*)(F.ws + WS_BB) + (size_t)(g * NST + p) * 32 + im * 16 + hs;
        x[cb][0] = *(const f32x4*)src; x[cb][1] = *(const f32x4*)(src + 4); }
}
__device__ __forceinline__ void ssm_bfrag_cvt(int lane, const f32x4 (&x)[8][2], bf16x8 (&bf)[8]) {
    const bool lo = (lane >> 4) >= 2;
#pragma unroll
    for (int cb = 0; cb < 8; ++cb) { const f32x4 x0 = x[cb][0], x1 = x[cb][1];
        float v[8] = {x0.x, x0.y, x0.z, x0.w, x1.x, x1.y, x1.z, x1.w};
        unsigned w[4];
#pragma unroll
        for (int j = 0; j < 4; ++j) { const unsigned hi = cvt_pk_bf16(v[2 * j], v[2 * j + 1]);
            const unsigned l2 = cvt_pk_bf16(v[2 * j] - bflo(hi), v[2 * j + 1] - bfhi(hi)); w[j] = lo ? l2 : hi; }
        v4u ww = (v4u){w[0], w[1], w[2], w[3]}; bf[cb] = __builtin_bit_cast(bf16x8, ww); }
}
__device__ __forceinline__ bf16x8 ssm_load_afrag(const bf16* U, int row0, int g, int lane) {
    return *(const bf16x8*)(U + (size_t)(row0 + (lane & 15)) * SW + g * GCH + 8 * ((lane >> 4) & 1));
}
__device__ __forceinline__ void ssm_bu16(const bf16x8 afr, const bf16x8 (&bf)[8], LAS float* bubuf, int lane) {
    LAS float* wp = bubuf + (4 * (lane >> 4)) * BUP + (lane & 15);
    f32x4 d[8];
#pragma unroll
    for (int cb = 0; cb < 8; ++cb) { d[cb] = __builtin_amdgcn_mfma_f32_16x16x32_bf16(afr, bf[cb], (f32x4){0.f, 0.f, 0.f, 0.f}, 0, 0, 0); MFMA_PIN(afr, bf[cb]); }
    MFMA_SETTLE();
#pragma unroll
    for (int cb = 0; cb < 8; ++cb) { wp[16 * cb] = d[cb][0]; wp[16 * cb + BUP] = d[cb][1]; wp[16 * cb + 2 * BUP] = d[cb][2]; wp[16 * cb + 3 * BUP] = d[cb][3]; }
    LDS_WAIT(); asm volatile("" ::: "memory");
}
__device__ __forceinline__ void ssm_load_u(const bf16* U, int r0, int nrows, int g, LAS float* ubuf, int lane) {
    if (lane < nrows) { const v4u* p = (const v4u*)(U + (size_t)(r0 + lane) * SW + g * GCH); const v4u a = p[0], b = p[1];
        LAS f32x4* o = (LAS f32x4*)(ubuf + lane * 16);
        o[0] = (f32x4){bflo(a.x), bfhi(a.x), bflo(a.y), bfhi(a.y)}; o[1] = (f32x4){bflo(a.z), bfhi(a.z), bflo(a.w), bfhi(a.w)};
        o[2] = (f32x4){bflo(b.x), bfhi(b.x), bflo(b.y), bfhi(b.y)}; o[3] = (f32x4){bflo(b.z), bfhi(b.z), bflo(b.w), bfhi(b.w)}; }
    LDS_WAIT(); asm volatile("" ::: "memory");
}
__device__ __forceinline__ void ssm_bu(const LAS float* ubuf, int t, const float (&bbr)[16], const float (&bbi)[16], float& bur, float& bui) {
    const LAS f32x4* up = (const LAS f32x4*)(ubuf + t * 16);
    float r0 = 0.f, r1 = 0.f, i0 = 0.f, i1 = 0.f;
#pragma unroll
    for (int q = 0; q < 4; ++q) { const f32x4 u = up[q];
        r0 = fmaf(u.x, bbr[4 * q + 0], r0); r1 = fmaf(u.y, bbr[4 * q + 1], r1); r0 = fmaf(u.z, bbr[4 * q + 2], r0); r1 = fmaf(u.w, bbr[4 * q + 3], r1);
        i0 = fmaf(u.x, bbi[4 * q + 0], i0); i1 = fmaf(u.y, bbi[4 * q + 1], i1); i0 = fmaf(u.z, bbi[4 * q + 2], i0); i1 = fmaf(u.w, bbi[4 * q + 3], i1); }
    bur = r0 + r1; bui = i0 + i1;
}
__device__ __forceinline__ void ssm_load_bb(Frame& F, int g, int lane, float (&bbr)[16], float (&bbi)[16]) {
    const f32x4* p = (const f32x4*)((const float*)(F.ws + WS_BB) + (size_t)(g * NST + lane) * 32);
#pragma unroll
    for (int q = 0; q < 4; ++q) { const f32x4 a = p[q], b = p[4 + q]; bbr[4 * q] = a.x; bbr[4 * q + 1] = a.y; bbr[4 * q + 2] = a.z; bbr[4 * q + 3] = a.w; bbi[4 * q] = b.x; bbi[4 * q + 1] = b.y; bbi[4 * q + 2] = b.z; bbi[4 * q + 3] = b.w; }
}
__device__ __forceinline__ void p5_phase(Frame& F) {
    LAS float* bubuf = (LAS float*)(F.lds + RING_OFF + F.wave * SSM_LDS_W);
    const bf16* U = (const bf16*)(F.ws + WS_U);
    const int g = F.gw & (NGRP - 1);
    f32x4 braw[8][2]; ssm_bfrag_raw(F, g, F.lane, braw);
    const f32x2 ab = ((const f32x2*)(F.ws + WS_ABAR))[g * NST + F.lane];
    bf16x8 nfr[4];
    { const int bc = F.gw >> 7, r0 = (bc / NCH) * SEQ + (bc % NCH) * TCH;
#pragma unroll
      for (int sub = 0; sub < 4; ++sub) nfr[sub] = ssm_load_afrag(U, r0 + 16 * sub, g, F.lane); }
    bf16x8 bf[8]; ssm_bfrag_cvt(F.lane, braw, bf);
    for (int it = F.gw; it < NB * NCH * NGRP; it += F.ngw) {
        bf16x8 afr[4];
#pragma unroll
        for (int sub = 0; sub < 4; ++sub) afr[sub] = nfr[sub];
        if (it + F.ngw < NB * NCH * NGRP) { const int bc = (it + F.ngw) >> 7, r0 = (bc / NCH) * SEQ + (bc % NCH) * TCH;
#pragma unroll
            for (int sub = 0; sub < 4; ++sub) nfr[sub] = ssm_load_afrag(U, r0 + 16 * sub, g, F.lane); }
        float sr = 0.f, si = 0.f;
#pragma unroll
        for (int sub = 0; sub < 4; ++sub) {
            ssm_bu16(afr[sub], bf, bubuf, F.lane);
#pragma unroll
            for (int tt = 0; tt < 16; ++tt) { const float bur = bubuf[tt * BUP + F.lane], bui = bubuf[tt * BUP + 64 + F.lane];
                const float nr = fmaf(ab.x, sr, fmaf(-ab.y, si, bur)), ni = fmaf(ab.x, si, fmaf(ab.y, sr, bui)); sr = nr; si = ni; }
            LDS_WAIT(); asm volatile("" ::: "memory");
        }
        ((f32x2*)(F.ws + WS_E))[(size_t)it * NST + F.lane] = (f32x2){sr, si};
    }
    if (!(F.gw & 1) && (F.gw >> 1) < NSAMP * 7) { const int item = F.gw >> 1;
        const int i = item / 7, part = item % 7, R = NPROMPT + i;
        const float* pr = (const float*)(F.ws + WS_PARTW) + (size_t)i * INW + part * 2048;
        bf16* dst = part == 0 ? (bf16*)(F.ws + WS_U) + (size_t)R * SW : part == 1 ? (bf16*)(F.ws + WS_GU) + (size_t)R * GW : part == 2 ? (bf16*)(F.ws + WS_GV) + (size_t)R * GW :
                    part < 5 ? (bf16*)(F.ws + WS_GS) + (size_t)R * D + (part - 3) * 2048 : (bf16*)(F.ws + WS_GG) + (size_t)R * D + (part - 5) * 2048;
        float ssq = 0.f;
#pragma unroll
        for (int it = 0; it < 4; ++it) {
            const int c = it * 512 + F.lane * 8;
            f32x4 z0 = (f32x4){0.f, 0.f, 0.f, 0.f}, z1 = z0;
#pragma unroll
            for (int ks = 0; ks < NSPLITW; ++ks) { const float* p = pr + (size_t)ks * NSAMP * INW + c; z0 = z0 + *(const f32x4*)p; z1 = z1 + *(const f32x4*)(p + 4); }
            if (part == 1 || part == 2) {
#pragma unroll
                for (int j = 0; j < 4; ++j) { z0[j] = fgelu(z0[j]); z1[j] = fgelu(z1[j]); } }
            if (part >= 3) {
#pragma unroll
                for (int j = 0; j < 4; ++j) { z0[j] = fsigmoid(z0[j]); z1[j] = fsigmoid(z1[j]); } }
            const v4u w = pg8::pack8(z0, z1);
            const float a0 = bflo(w.x), a1 = bfhi(w.x), a2 = bflo(w.y), a3 = bfhi(w.y), a4 = bflo(w.z), a5 = bfhi(w.z), a6 = bflo(w.w), a7 = bfhi(w.w);
            ssq += (a0 * a0 + a1 * a1) + (a2 * a2 + a3 * a3) + (a4 * a4 + a5 * a5) + (a6 * a6 + a7 * a7);
            *(v4u*)(dst + c) = w;
        }
        if (part == 2) { ssq = wave_sum(ssq); if (F.lane == 0) ((float*)(F.ws + WS_RS))[R] = 1.0f / sqrtf(ssq * (1.0f / GW) + EPS); }
    }
    for (int m = F.gw; m < NPROMPT; m += F.ngw) {
        const v4u* p = (const v4u*)((const bf16*)(F.ws + WS_GV) + (size_t)m * GW) + F.lane; float s = 0.f;
#pragma unroll
        for (int j = 0; j < 4; ++j) { const v4u w = p[64 * j];
            const float a0 = bflo(w.x), a1 = bfhi(w.x), a2 = bflo(w.y), a3 = bfhi(w.y), a4 = bflo(w.z), a5 = bfhi(w.z), a6 = bflo(w.w), a7 = bfhi(w.w);
            s += (a0 * a0 + a1 * a1) + (a2 * a2 + a3 * a3) + (a4 * a4 + a5 * a5) + (a6 * a6 + a7 * a7); }
        s = wave_sum(s);
        if (F.lane == 0) ((float*)(F.ws + WS_RS))[m] = 1.0f / sqrtf(s * (1.0f / GW) + EPS);
    }
}
__device__ __forceinline__ void ssm_out16(const LAS bf16* sbuf, const float (&uv)[4], const bf16x8 (&cf)[4], float dskip, bf16* Yrow0  , int lane) {
    f32x4 acc = (f32x4){0.f, 0.f, 0.f, 0.f};
    const LAS bf16* ap = sbuf + (lane & 15) * 136 + 8 * (lane >> 4);
    bf16x8 a[4];
#pragma unroll
    for (int kk = 0; kk < 4; ++kk) a[kk] = *(const LAS bf16x8*)(ap + 32 * kk);
#pragma unroll
    for (int kk = 0; kk < 4; ++kk) { acc = __builtin_amdgcn_mfma_f32_16x16x32_bf16(a[kk], cf[kk], acc, 0, 0, 0); MFMA_PIN(a[kk], cf[kk]); }
    MFMA_SETTLE();
    const int h = lane & 15, tq = 4 * (lane >> 4);
#pragma unroll
    for (int r = 0; r < 4; ++r) { const float y = acc[r] + dskip * uv[r]; Yrow0[(size_t)(tq + r) * SW + h] = (bf16)(cvt_pk_bf16(fgelu(y), 0.f) & 0xffffu); }
}
__device__ __forceinline__ void ssm_c_raw(const Args& A, int g, int lane, f32x4 (&y)[4][2], float& dskip) {
    const int h = lane & 15, kq = 8 * (lane >> 4);
#pragma unroll
    for (int kk = 0; kk < 4; ++kk) { const int k0 = 32 * kk + kq; const float* src = (k0 < 64 ? A.in[15] : A.in[16]) + ((size_t)(g * GCH + h) * NST + (k0 & 63));
        y[kk][0] = *(const f32x4*)src; y[kk][1] = *(const f32x4*)(src + 4); }
    dskip = A.in[17][g * GCH + h];
}
__device__ __forceinline__ void ssm_c_cvt(int lane, const f32x4 (&y)[4][2], bf16x8 (&cf)[4]) {
    const int kq = 8 * (lane >> 4);
#pragma unroll
    for (int kk = 0; kk < 4; ++kk) { const int k0 = 32 * kk + kq; const float sg = k0 < 64 ? 1.f : -1.f; const f32x4 a = y[kk][0], b = y[kk][1];
        const unsigned w0 = cvt_pk_bf16(sg * a.x, sg * a.y), w1 = cvt_pk_bf16(sg * a.z, sg * a.w), w2 = cvt_pk_bf16(sg * b.x, sg * b.y), w3 = cvt_pk_bf16(sg * b.z, sg * b.w);
        v4u w = (v4u){w0, w1, w2, w3}; cf[kk] = __builtin_bit_cast(bf16x8, w); }
}
__device__ __forceinline__ void ssm_put_s(LAS bf16* sbuf, int tt, int lane, float sr, float si) {
    const unsigned w = cvt_pk_bf16(sr, si); sbuf[tt * 136 + lane] = (bf16)(w & 0xffffu); sbuf[tt * 136 + 64 + lane] = (bf16)(w >> 16);
}
__device__ __forceinline__ void p6_ssm(Frame& F, const Args& A) {
    LAS float* bubuf = (LAS float*)(F.lds + RING_OFF + F.wave * SSM_LDS_W);
    LAS bf16* sbuf = (LAS bf16*)(F.lds + RING_OFF + F.wave * SSM_LDS_W + SSM_BU_BYTES);
    const bf16* U = (const bf16*)(F.ws + WS_U); bf16* Y = (bf16*)(F.ws + WS_Y);
    const int g = F.gw & (NGRP - 1);
    const f32x2 ab = ((const f32x2*)(F.ws + WS_ABAR))[g * NST + F.lane];
    f32x4 craw[4][2]; float dskip; ssm_c_raw(A, g, F.lane, craw, dskip);
    const f32x2 aT = ((const f32x2*)(F.ws + WS_AT))[g * NST + F.lane];
    f32x4 braw[8][2]; ssm_bfrag_raw(F, g, F.lane, braw);
    bf16x8 cf[4]; bf16x8 bf[8];
    {
    bf16x8 nfr[4]; unsigned short nur[4][4];
#define P6_ITEM_R0(itv) ({ const int _bc = (itv) >> 7, _b = _bc / NCH, _ci = _bc % NCH; _b * SEQ + ((_b & 1) ? _ci : NCH - 1 - _ci) * TCH; })
#define P6_LOAD(r0v) do { _Pragma("unroll") for (int sub = 0; sub < 4; ++sub) { nfr[sub] = ssm_load_afrag(U, (r0v) + 16 * sub, g, F.lane); \
        _Pragma("unroll") for (int r = 0; r < 4; ++r) nur[sub][r] = U[(size_t)((r0v) + 16 * sub + 4 * (F.lane >> 4) + r) * SW + g * GCH + (F.lane & 15)]; } } while (0)
    { const int r0n = P6_ITEM_R0(F.gw); P6_LOAD(r0n); }
    ssm_c_cvt(F.lane, craw, cf); ssm_bfrag_cvt(F.lane, braw, bf);
    for (int it = F.gw; it < NB * NCH * NGRP; it += F.ngw) {
        const int bc = it >> 7, b = bc / NCH, cidx = bc % NCH, c = (b & 1) ? cidx : NCH - 1 - cidx, r0 = b * SEQ + c * TCH;
        bf16x8 afr[4]; unsigned short ur[4][4];
#pragma unroll
        for (int sub = 0; sub < 4; ++sub) { afr[sub] = nfr[sub];
#pragma unroll
            for (int r = 0; r < 4; ++r) ur[sub][r] = nur[sub][r]; }
        if (it + F.ngw < NB * NCH * NGRP) { const int r0n = P6_ITEM_R0(it + F.ngw); P6_LOAD(r0n); }
        float sr = 0.f, si = 0.f;
        { const f32x2* E = (const f32x2*)(F.ws + WS_E) + ((size_t)(b * NCH) * NGRP + g) * NST + F.lane;
          for (int c0 = 0; c0 < c; c0 += 8) {
              f32x2 e[8];
#pragma unroll
              for (int k = 0; k < 8; ++k) e[k] = (c0 + k < c) ? E[(size_t)(c0 + k) * NGRP * NST] : (f32x2){0.f, 0.f};
#pragma unroll
              for (int k = 0; k < 8; ++k) if (c0 + k < c) { const float nr = fmaf(aT.x, sr, fmaf(-aT.y, si, e[k].x)), ni = fmaf(aT.x, si, fmaf(aT.y, sr, e[k].y)); sr = nr; si = ni; } } }
#pragma unroll
        for (int sub = 0; sub < 4; ++sub) {
            ssm_bu16(afr[sub], bf, bubuf, F.lane);
#pragma unroll
            for (int tt = 0; tt < 16; ++tt) { const float bur = bubuf[tt * BUP + F.lane], bui = bubuf[tt * BUP + 64 + F.lane];
                const float nr = fmaf(ab.x, sr, fmaf(-ab.y, si, bur)), ni = fmaf(ab.x, si, fmaf(ab.y, sr, bui)); sr = nr; si = ni;
                ssm_put_s(sbuf, tt, F.lane, sr, si); }
            LDS_WAIT(); asm volatile("" ::: "memory");
            float uv[4];
#pragma unroll
            for (int r = 0; r < 4; ++r) uv[r] = __uint_as_float(((unsigned)ur[sub][r]) << 16);
            ssm_out16(sbuf, uv, cf, dskip, Y + (size_t)(r0 + sub * 16) * SW + g * GCH, F.lane);
            LDS_WAIT(); asm volatile("" ::: "memory");
        }
        if (c == NCH - 1) { F.out[O_PRE + (size_t)(b * NGRP + g) * NST + F.lane] = sr; F.out[O_PIM + (size_t)(b * NGRP + g) * NST + F.lane] = si; }
    } }
    {
    float bbr[16], bbi[16]; ssm_load_bb(F, g, F.lane, bbr, bbi);
    if (((F.gw >> 7) & 1) == (g & 1)) {
        const int sb = F.gw >> 8, r0 = NPROMPT + sb * 16;
        ssm_load_u(U, r0, 16, g, bubuf, F.lane);
#pragma unroll 4
        for (int i = 0; i < 16; ++i) { const size_t so = (size_t)((sb * 16 + i) * NGRP + g) * NST + F.lane;
            const float s0r = A.in[2][so], s0i = A.in[3][so]; float bur, bui; ssm_bu(bubuf, i, bbr, bbi, bur, bui);
            const float nr = fmaf(ab.x, s0r, fmaf(-ab.y, s0i, bur)), ni = fmaf(ab.x, s0i, fmaf(ab.y, s0r, bui));
            F.out[O_SRE + so] = nr; F.out[O_SIM + so] = ni; ssm_put_s(sbuf, i, F.lane, nr, ni); }
        LDS_WAIT(); asm volatile("" ::: "memory");
        float uv[4];
#pragma unroll
        for (int r = 0; r < 4; ++r) uv[r] = bubuf[(4 * (F.lane >> 4) + r) * 16 + (F.lane & 15)];
        ssm_out16(sbuf, uv, cf, dskip, Y + (size_t)r0 * SW + g * GCH, F.lane);
        LDS_WAIT(); asm volatile("" ::: "memory");
    } }
}
constexpr int VLD = 132;
__device__ __forceinline__ void p6_gmlp(Frame& F, const Args& A) {
    LAS bf16* vt = (LAS bf16*)(F.lds + RING_OFF);
    const bf16* GVp = (const bf16*)(F.ws + WS_GV); const bf16* GUp = (const bf16*)(F.ws + WS_GU); bf16* S2 = (bf16*)(F.ws + WS_S2);
    const float* RS = (const float*)(F.ws + WS_RS); const float* gnv = A.in[19]; const float* Wsp = A.in[20]; const float* bsp = A.in[21];
    const int lane = F.lane, w = F.wave;
    const int tcol = 16 * w + (lane & 15), kq = 8 * (lane >> 4), nks = (w >> 1) + 1;
    for (int it = blockIdx.x; it < NB * (SEQ / CHUNK) * NHEAD; it += gridDim.x) {
        const int g = it & 15, bn = it >> 4, R0 = bn * CHUNK, C0 = g * HD;
        v4u raw[4]; float rs[4];
#pragma unroll
        for (int q = 0; q < 4; ++q) { const int idx = q * 512 + F.tid, s = idx >> 4, e8 = (idx & 15) * 8; raw[q] = *(const v4u*)(GVp + (size_t)(R0 + s) * GW + C0 + e8); rs[q] = RS[R0 + s]; }
        const int e8c = (F.tid & 15) * 8; const f32x4 g0 = *(const f32x4*)(gnv + C0 + e8c), g1 = *(const f32x4*)(gnv + C0 + e8c + 4);
        f32x4 wa[4], wb[4];
#pragma unroll
        for (int ks = 0; ks < 4; ++ks) if (ks < nks) { const float* wp = Wsp + ((size_t)(g * CHUNK + tcol) * CHUNK + 32 * ks + kq); wa[ks] = *(const f32x4*)wp; wb[ks] = *(const f32x4*)(wp + 4); }
        const size_t rowoff = (size_t)(R0 + tcol) * GW + C0 + 4 * (lane >> 4);
        v2u gu2[8];
#pragma unroll
        for (int m = 0; m < 8; ++m) gu2[m] = *(const v2u*)(GUp + rowoff + 16 * m);
        const float bias = bsp[g * CHUNK + tcol];
        __syncthreads();
#pragma unroll
        for (int q = 0; q < 4; ++q) { const int idx = q * 512 + F.tid, s = idx >> 4; const float r = rs[q]; const v4u rw = raw[q];
            v2u o0, o1; o0.x = cvt_pk_bf16(bflo(rw.x) * r * g0.x, bfhi(rw.x) * r * g0.y); o0.y = cvt_pk_bf16(bflo(rw.y) * r * g0.z, bfhi(rw.y) * r * g0.w);
            o1.x = cvt_pk_bf16(bflo(rw.z) * r * g1.x, bfhi(rw.z) * r * g1.y); o1.y = cvt_pk_bf16(bflo(rw.w) * r * g1.z, bfhi(rw.w) * r * g1.w);
            LAS v2u* d = (LAS v2u*)(vt + s * VLD + e8c); d[0] = o0; d[1] = o1; }
        __syncthreads();
        f32x4 acc[8];
#pragma unroll
        for (int m = 0; m < 8; ++m) acc[m] = (f32x4){0.f, 0.f, 0.f, 0.f};
#pragma unroll
        for (int ks = 0; ks < 4; ++ks) if (ks < nks) {
            const int s0 = 32 * ks + kq;
            float wv[8] = {wa[ks].x, wa[ks].y, wa[ks].z, wa[ks].w, wb[ks].x, wb[ks].y, wb[ks].z, wb[ks].w};
#pragma unroll
            for (int j = 0; j < 8; ++j) wv[j] = (s0 + j <= tcol) ? wv[j] : 0.f;
            v4u bw = (v4u){cvt_pk_bf16(wv[0], wv[1]), cvt_pk_bf16(wv[2], wv[3]), cvt_pk_bf16(wv[4], wv[5]), cvt_pk_bf16(wv[6], wv[7])}; const bf16x8 bfrag = __builtin_bit_cast(bf16x8, bw);
#pragma unroll
            for (int m = 0; m < 8; ++m) {
                const LAS bf16* ap = vt + s0 * VLD + 16 * m + (lane & 15);
                unsigned e0 = ap[0], e1 = ap[VLD], e2 = ap[2 * VLD], e3 = ap[3 * VLD], e4 = ap[4 * VLD], e5 = ap[5 * VLD], e6 = ap[6 * VLD], e7 = ap[7 * VLD];
                v4u aw = (v4u){e0 | (e1 << 16), e2 | (e3 << 16), e4 | (e5 << 16), e6 | (e7 << 16)}; const bf16x8 afrag = __builtin_bit_cast(bf16x8, aw);
                acc[m] = __builtin_amdgcn_mfma_f32_16x16x32_bf16(afrag, bfrag, acc[m], 0, 0, 0); MFMA_PIN(afrag, bfrag);
            }
        }
        MFMA_SETTLE();
#pragma unroll
        for (int m = 0; m < 8; ++m) { const v2u gw2 = gu2[m];
            v2u o; o.x = cvt_pk_bf16(bflo(gw2.x) * (acc[m][0] + bias), bfhi(gw2.x) * (acc[m][1] + bias)); o.y = cvt_pk_bf16(bflo(gw2.y) * (acc[m][2] + bias), bfhi(gw2.y) * (acc[m][3] + bias));
            *(v2u*)(S2 + rowoff + 16 * m) = o; }
    }
    __syncthreads();
    if ((F.gw & 15) == 0) { const int i = F.gw >> 4;
        const int R = NPROMPT + i; const float rs = RS[R];
#pragma unroll
        for (int j = 0; j < 4; ++j) { const int e8 = (j * 64 + lane) * 8, g = e8 >> 7;
            const v4u raw = *(const v4u*)(GVp + (size_t)R * GW + e8), gur = *(const v4u*)(GUp + (size_t)R * GW + e8);
            const f32x4 g0 = *(const f32x4*)(gnv + e8), g1 = *(const f32x4*)(gnv + e8 + 4);
            const f32x4 v0 = (f32x4){bflo(raw.x) * rs * g0.x, bfhi(raw.x) * rs * g0.y, bflo(raw.y) * rs * g0.z, bfhi(raw.y) * rs * g0.w};
            const f32x4 v1 = (f32x4){bflo(raw.z) * rs * g1.x, bfhi(raw.z) * rs * g1.y, bflo(raw.w) * rs * g1.z, bfhi(raw.w) * rs * g1.w};
            *(f32x4*)(F.out + O_V + (size_t)i * GW + e8) = v0; *(f32x4*)(F.out + O_V + (size_t)i * GW + e8 + 4) = v1;
            const float w00 = Wsp[(size_t)g * CHUNK * CHUNK], b0 = bsp[g * CHUNK];
            f32x4 u0, u1; pg8::unpack8(gur, u0, u1);
            *(v4u*)(S2 + (size_t)R * GW + e8) = pg8::pack8(u0 * (v0 * w00 + b0), u1 * (v1 * w00 + b0)); }
    }
}

__global__ void __launch_bounds__(NWAVES * 64, 2) mk_fwd(Args args) {
    extern __shared__ __attribute__((aligned(16))) unsigned char lds[];
    Frame F;
    F.lds = (LAS unsigned char*)lds;
    volatile LAS unsigned* MISC = (volatile LAS unsigned*)(F.lds + MISC_OFF);
    F.tid = threadIdx.x; F.lane = F.tid & 63; F.wave = __builtin_amdgcn_readfirstlane(F.tid >> 6);
    F.gw = blockIdx.x * NWAVES + F.wave; F.ngw = gridDim.x * NWAVES;
    F.ws = args.ws; F.out = args.out;
    gu32* ctl = (gu32*)(args.ws + WS_CTL);
    for (int u = F.tid; u < (LDS_BYTES - LDSCTL_OFF) / 4; u += NWAVES * 64) ((LAS unsigned*)(F.lds + LDSCTL_OFF))[u] = 0u;
    __syncthreads();
    XcdBarrier bar; bar.bar = (unsigned*)(ctl + CW_BAR); bar.x = 0; bar.st = nullptr;
    if (!MK_SPLIT) bar = xcd_barrier_post((unsigned*)(ctl + CW_BAR), MISC + 8);
#define GRID_BAR() do { if (!MK_SPLIT) xcd_barrier(bar); } while (0)
    const int lo = args.ph_lo, hi = args.ph_hi, G = gridDim.x, bx = blockIdx.x;
#ifndef PH_MASK
#define PH_MASK 0xffff
#endif
#ifndef DUP_MASK
#define DUP_MASK 0
#endif
#define NREP(k) (((DUP_MASK >> (k)) & 1) ? 2 : 1)
#define IN(k) (((PH_MASK >> (k)) & 1) && lo <= (k) && (k) < hi)
#define BOTH(k) (IN(k) && IN((k) + 1))
    bf16* const Hb = (bf16*)(args.ws + WS_H); bf16* const ACT = (bf16*)(args.ws + WS_ACT); bf16* const XR = (bf16*)(args.ws + WS_XRES);

    if (IN(0)) _Pragma("unroll") for (int rep = 0; rep < NREP(0); ++rep) { p0_prologue(F, args); if (BOTH(0)) GRID_BAR(); }
    if (IN(1)) _Pragma("unroll") for (int rep = 0; rep < NREP(1); ++rep) {
        if (bx < NG1) {
        pg8::Gemm g{Hb, (const bf16*)(args.ws + WS_WGU1), M, 2 * DFF, D}; pg8::SampleOrderGated S; S.init(2 * DFF, D, NG1, bx, 1);
        S.ctr = (const unsigned*)(args.ws + WS_CTL) + CW_GATE; S.nconv = (unsigned)(G - NG1); S.base = S.nconv * (unsigned)((NPN1 - GATE_G0 + GATE_SG - 1) / GATE_SG) * rep; S.g0 = GATE_G0; S.sg = GATE_SG; S.seen = 0;
        pg8::EpiSwiGLU E{ACT, DFF};
        pg8::gemm_phase<pg8::EpiSwiGLU, pg8::SampleOrderGated, PG8_ALIGN, PG8_SP2>(F.lds + RING_OFF, g, S, E);
        } else { convert_beside_ffn1(F, args, (bx - NG1) * NWAVES + F.wave, (G - NG1) * NWAVES); ssm_discretise(F, args, (bx - NG1) * (NWAVES * 64) + F.tid); }
        if (BOTH(1)) GRID_BAR();
    }
    if (IN(2)) _Pragma("unroll") for (int rep = 0; rep < NREP(2); ++rep) {
        pg8::Gemm g{ACT, (const bf16*)(args.ws + WS_WD1), M, D, DFF}; pg8::SampleOrder S; S.init(D, DFF, G, bx, NSPLIT);
        pg8::EpiRes E{XR, D, rep == 0 ? 0.5f : 0.0f, (float*)(args.ws + WS_PART), args.in[0]};
        pg8::gemm_phase<pg8::EpiRes, pg8::SampleOrder, PG8_ALIGN, PG8_SP2>(F.lds + RING_OFF, g, S, E);
        if (BOTH(2)) GRID_BAR();
    }
    if (IN(3)) _Pragma("unroll") for (int rep = 0; rep < NREP(3); ++rep) { norm_phase(F, args.in[8], NSPLIT, 0.5f, args.in[1]); if (BOTH(3)) GRID_BAR(); }
    if (IN(4)) _Pragma("unroll") for (int rep = 0; rep < NREP(4); ++rep) {
        if (bx < NG4) {
        pg8::Gemm g{Hb, (const bf16*)(args.ws + WS_WIN), M, INW, D}; pg8::SampleOrder S; S.init(INW, D, NG4, bx, NSPLITW);
        pg8::EpiWin E{(bf16*)(args.ws + WS_U), (WS_GU - WS_U) / 2, (WS_GV - WS_U) / 2, (WS_GS - WS_U) / 2, (WS_GG - WS_U) / 2, (float*)(args.ws + WS_PARTW)};
        pg8::gemm_phase<pg8::EpiWin, pg8::SampleOrder, PG8_ALIGN, PG8_SP2>(F.lds + RING_OFF, g, S, E);
        } else convert_beside_win(F, args, (bx - NG4) * NWAVES + F.wave, (G - NG4) * NWAVES);
        if (BOTH(4)) GRID_BAR();
    }
    if (IN(5)) _Pragma("unroll") for (int rep = 0; rep < NREP(5); ++rep) { p5_phase(F); if (BOTH(5)) GRID_BAR(); }
    if (IN(6)) _Pragma("unroll") for (int rep = 0; rep < NREP(6); ++rep) { p6_gmlp(F, args); p6_ssm(F, args); if (BOTH(6)) GRID_BAR(); }
    if (IN(7)) _Pragma("unroll") for (int rep = 0; rep < NREP(7); ++rep) {
        pg8::Gemm g{(const bf16*)(args.ws + WS_S2), (const bf16*)(args.ws + WS_WGOUT), M, D, GW}; pg8::SampleOrder S; S.init(D, GW, G, bx, NSPLITG);
        pg8::EpiGout E{(const bf16*)(args.ws + WS_GG), (bf16*)(args.ws + WS_T), D, (float*)(args.ws + WS_PARTG)};
        pg8::gemm_phase<pg8::EpiGout, pg8::SampleOrder, PG8_ALIGN, PG8_SP2>(F.lds + RING_OFF, g, S, E);
        if (BOTH(7)) GRID_BAR();
    }
    if (IN(8)) _Pragma("unroll") for (int rep = 0; rep < NREP(8); ++rep) {
        pg8::Gemm g{(const bf16*)(args.ws + WS_Y), (const bf16*)(args.ws + WS_WGLU), M, 2 * D, SW}; pg8::SampleOrder S; S.init(2 * D, SW, G, bx, 1);
        pg8::EpiGlu E{(const bf16*)(args.ws + WS_GS), (const bf16*)(args.ws + WS_T), Hb, D, (const bf16*)(args.ws + WS_GG), (const float*)(args.ws + WS_PARTG)};
        pg8::gemm_phase<pg8::EpiGlu, pg8::SampleOrder, PG8_ALIGN, PG8_SP2>(F.lds + RING_OFF, g, S, E);
        if (BOTH(8)) GRID_BAR();
    }
    if (IN(9)) _Pragma("unroll") for (int rep = 0; rep < NREP(9); ++rep) {
        pg8::Gemm g{Hb, (const bf16*)(args.ws + WS_WOUT), M, D, D}; pg8::SampleOrder S; S.init(D, D, G, bx, NSPLIT);
        pg8::EpiRes E{XR, D, rep == 0 ? 1.0f : 0.0f, (float*)(args.ws + WS_PART), nullptr};
        pg8::gemm_phase<pg8::EpiRes, pg8::SampleOrder, PG8_ALIGN, PG8_SP2>(F.lds + RING_OFF, g, S, E);
        if (BOTH(9)) GRID_BAR();
    }
    if (IN(10)) _Pragma("unroll") for (int rep = 0; rep < NREP(10); ++rep) { norm_phase(F, args.in[24], rep == 0 ? NSPLIT : 0, 1.0f, nullptr); if (BOTH(10)) GRID_BAR(); }
    if (IN(11)) _Pragma("unroll") for (int rep = 0; rep < NREP(11); ++rep) {
        if (bx < NG11) {
        pg8::Gemm g{Hb, (const bf16*)(args.ws + WS_WGU2), M, 2 * DFF, D}; pg8::SampleOrder S; S.init(2 * DFF, D, NG11, bx, 1);
        pg8::EpiSwiGLU E{ACT, DFF};
        pg8::gemm_phase<pg8::EpiSwiGLU, pg8::SampleOrder, PG8_ALIGN, PG8_SP2>(F.lds + RING_OFF, g, S, E);
        } else convert_beside_ffn2(F, args, (bx - NG11) * NWAVES + F.wave, (G - NG11) * NWAVES);
        if (BOTH(11)) GRID_BAR();
    }
    if (IN(12)) _Pragma("unroll") for (int rep = 0; rep < NREP(12); ++rep) {
        pg8::Gemm g{ACT, (const bf16*)(args.ws + WS_WD2), M, D, DFF}; pg8::SampleOrder S; S.init(D, DFF, G, bx, NSPLIT);
        pg8::EpiRes E{XR, D, rep == 0 ? 0.5f : 0.0f, (float*)(args.ws + WS_PART), nullptr};
        pg8::gemm_phase<pg8::EpiRes, pg8::SampleOrder, PG8_ALIGN, PG8_SP2>(F.lds + RING_OFF, g, S, E);
        if (BOTH(12)) GRID_BAR();
    }
    if (IN(13)) _Pragma("unroll") for (int rep = 0; rep < NREP(13); ++rep) { final_norm_phase(F, args, NSPLIT, 0.5f); }
#undef IN
#undef BOTH
}

extern "C" void kernel_launch(void* const* d_in, const int* in_sizes, int n_in, void* d_out, int out_size, void* d_ws, size_t ws_size, hipStream_t stream) {
    static int grid = 0;
    if (grid == 0) {
        if (n_in != 29 || (size_t)out_size != O_END || ws_size < WS_END) { fprintf(stderr, "kernel_launch: unexpected shapes (n_in %d, out %d, ws %zu); nothing launched\n", n_in, out_size, ws_size); grid = -1; return; }
        int dev = 0, cus = 0, per_cu = 0;
        if (hipGetDevice(&dev) != hipSuccess || hipDeviceGetAttribute(&cus, hipDeviceAttributeMultiprocessorCount, dev) != hipSuccess) { fprintf(stderr, "kernel_launch: device query failed\n"); grid = -1; return; }
        if (hipFuncSetAttribute((const void*)mk_fwd, hipFuncAttributeMaxDynamicSharedMemorySize, LDS_BYTES) != hipSuccess) { fprintf(stderr, "kernel_launch: hipFuncSetAttribute failed\n"); grid = -1; return; }
        if (hipOccupancyMaxActiveBlocksPerMultiprocessor(&per_cu, (const void*)mk_fwd, NWAVES * 64, LDS_BYTES) != hipSuccess || per_cu < 1) fprintf(stderr, "kernel_launch: note: occupancy query reports %d workgroups per CU\n", per_cu);
        (void)hipGetLastError();
        if (cus < 256) { fprintf(stderr, "kernel_launch: %d CUs; this build needs 256\n", cus); grid = -1; return; }
        grid = 256;
        if (grid % 16 != 0) { fprintf(stderr, "kernel_launch: grid %d is not a multiple of 16\n", grid); grid = -1; return; }
    }
    if (grid < 0) return;
    (void)in_sizes;
    if (hipMemsetAsync((char*)d_ws + WS_CTL, 0, CTL_ZERO_BYTES, stream) != hipSuccess) { fprintf(stderr, "kernel_launch: memset failed\n"); return; }
    Args a{};
    for (int i = 0; i < 29; ++i) a.in[i] = (const float*)d_in[i];
    a.out = (float*)d_out; a.ws = (unsigned char*)d_ws;
#if MK_SPLIT
    for (int p = 0; p < N_PHASES; ++p) { a.ph_lo = p; a.ph_hi = p + 1; hipLaunchKernelGGL(mk_fwd, dim3(grid), dim3(NWAVES * 64), LDS_BYTES, stream, a); }
#else
    a.ph_lo = 0; a.ph_hi = N_PHASES;
    hipLaunchKernelGGL(mk_fwd, dim3(grid), dim3(NWAVES * 64), LDS_BYTES, stream, a);
#endif
    const hipError_t le = hipPeekAtLastError();
    if (le != hipSuccess) fprintf(stderr, "kernel_launch: launch failed: %s\n", hipGetErrorName(le));
}
```
